# Optimizing an MI355X kernel written in HIP

```python
import math
import jax, jax.numpy as jnp
from jax import lax
import numpy as np

D_MODEL = 1024
BATCH = 4
SEQ = 4096
DEPTH = 1

GRID_W = 64
CTX_LEN = 256
N_HEADS = 8
QK_NOPE_DIM = 64
QK_ROPE_DIM = 32
V_HEAD_DIM = 64
Q_LORA_RANK = 256
KV_LORA_RANK = 128
ATTN_WIDTH = N_HEADS * V_HEAD_DIM
MLA_IN_WIDTH = Q_LORA_RANK + KV_LORA_RANK + QK_ROPE_DIM
ROPE_BASE = 10000.0
SOFTMAX_SCALE = (QK_NOPE_DIM + QK_ROPE_DIM) ** -0.5
Q_BLOCK = 128
SSM_WIDTH = D_MODEL - ATTN_WIDTH
SSM_GROUP = 16
N_SSM_GROUPS = SSM_WIDTH // SSM_GROUP
SSM_STATE = 64
DT_MIN = 0.001
DT_MAX = 0.1
IN_PROJ_WIDTH = MLA_IN_WIDTH + SSM_WIDTH
MIX_WIDTH = ATTN_WIDTH + SSM_WIDTH
N_EXPERT_GROUPS = 4
EXPERTS_PER_GROUP = 8
N_EXPERTS = N_EXPERT_GROUPS * EXPERTS_PER_GROUP
EXPERT_TOP_K = 2
D_FF_EXPERT = 256
ALPHA = (2 * DEPTH) ** 0.25
BETA = (8 * DEPTH) ** -0.25
EPS = 1e-6

kernel_name = "hymba_mla_s5_hmoe_deepnorm_dit"


def layer_norm(x, g, b):
    xf = x.astype(jnp.float32)
    mu = jnp.mean(xf, -1, keepdims=True)
    var = jnp.mean(jnp.square(xf - mu), -1, keepdims=True)
    return ((xf - mu) * lax.rsqrt(var + EPS) * g + b).astype(x.dtype)


def rms_norm(x, g):
    xf = x.astype(jnp.float32)
    return (xf * lax.rsqrt(jnp.mean(jnp.square(xf), -1, keepdims=True) + EPS) * g).astype(x.dtype)


def modulate(x, shift, scale):
    return x * (1.0 + scale) + shift


def axial_rope_tables(n_tok):
    rows = n_tok // GRID_W
    row = jnp.repeat(jnp.arange(rows), GRID_W).astype(jnp.float32)
    col = jnp.tile(jnp.arange(GRID_W), rows).astype(jnp.float32)
    axis_dim = QK_ROPE_DIM // 2
    inv_freq = ROPE_BASE ** (-jnp.arange(0, axis_dim, 2, dtype=jnp.float32) / axis_dim)
    ang = jnp.concatenate([row[:, None] * inv_freq, col[:, None] * inv_freq], -1)
    ang = jnp.concatenate([ang, ang], -1)
    return jnp.cos(ang), jnp.sin(ang)


def apply_rope(t, cos, sin):
    t1, t2 = jnp.split(t, 2, axis=-1)
    rot = jnp.concatenate([-t2, t1], -1)
    return (t * cos + rot * sin).astype(t.dtype)


def mla_project(p, q_norm_g, kv_norm_g, w_uq, w_ukv, rope):
    lead = p.shape[:-1]
    cq = p[..., :Q_LORA_RANK]
    ckv = p[..., Q_LORA_RANK:Q_LORA_RANK + KV_LORA_RANK]
    k_rope = p[..., Q_LORA_RANK + KV_LORA_RANK:MLA_IN_WIDTH]
    q = (rms_norm(cq, q_norm_g) @ w_uq).reshape(*lead, N_HEADS, QK_NOPE_DIM + QK_ROPE_DIM)
    kv = (rms_norm(ckv, kv_norm_g) @ w_ukv).reshape(*lead, N_HEADS, QK_NOPE_DIM + V_HEAD_DIM)
    q_nope, q_rope = q[..., :QK_NOPE_DIM], q[..., QK_NOPE_DIM:]
    k_nope, v = kv[..., :QK_NOPE_DIM], kv[..., QK_NOPE_DIM:]
    if rope is not None:
        cos, sin = rope
        q_rope = apply_rope(q_rope, cos[:, None], sin[:, None])
        k_rope = apply_rope(k_rope, cos, sin)
    return q_nope, q_rope, k_nope, k_rope, v


def mla_attend(q_nope, q_rope, k_nope, k_rope, v):
    s = (jnp.einsum('bqhd,bkhd->bhqk', q_nope, k_nope)
         + jnp.einsum('bqhr,bkr->bhqk', q_rope, k_rope))
    p = jax.nn.softmax(s.astype(jnp.float32) * SOFTMAX_SCALE, axis=-1).astype(v.dtype)
    return jnp.einsum('bhqk,bkhd->bqhd', p, v)


def latent_attention(q_nope, q_rope, k_nope, k_rope, v):
    b, n = q_nope.shape[:2]
    nblk = n // Q_BLOCK

    def to_blocks(t):
        return jnp.moveaxis(t.reshape(b, nblk, Q_BLOCK, *t.shape[2:]), 1, 0)

    out = lax.map(lambda qs: mla_attend(qs[0], qs[1], k_nope, k_rope, v),
                  (to_blocks(q_nope), to_blocks(q_rope)))
    return jnp.moveaxis(out, 0, 1).reshape(b, n, ATTN_WIDTH)


def s5_discretise(a_re, a_im, log_dt, b_re, b_im):
    f32 = jnp.float32
    a_re, a_im = a_re.astype(f32), a_im.astype(f32)
    dt = jnp.exp(log_dt.astype(f32))[:, None]
    mag = jnp.exp(a_re * dt)
    abar_re, abar_im = mag * jnp.cos(a_im * dt), mag * jnp.sin(a_im * dt)
    den = jnp.square(a_re) + jnp.square(a_im)
    num_re = abar_re - 1.0
    coef_re = (num_re * a_re + abar_im * a_im) / den
    coef_im = (abar_im * a_re - num_re * a_im) / den
    b_re, b_im = b_re.astype(f32), b_im.astype(f32)
    bbar_re = coef_re[..., None] * b_re - coef_im[..., None] * b_im
    bbar_im = coef_re[..., None] * b_im + coef_im[..., None] * b_re
    return abar_re, abar_im, bbar_re, bbar_im


def _complex_affine_combine(e1, e2):
    a1r, a1i, b1r, b1i = e1
    a2r, a2i, b2r, b2i = e2
    return (a2r * a1r - a2i * a1i, a2r * a1i + a2i * a1r,
            a2r * b1r - a2i * b1i + b2r, a2r * b1i + a2i * b1r + b2i)


def s5_states(u, s0_re, s0_im, abar_re, abar_im, bbar_re, bbar_im, reverse):
    bsz, n = u.shape[:2]
    uf = u.astype(jnp.float32).reshape(bsz, n, N_SSM_GROUPS, SSM_GROUP)
    if reverse:
        uf = uf[:, ::-1]
    bu_re = jnp.einsum('bngh,gph->bngp', uf, bbar_re)
    bu_im = jnp.einsum('bngh,gph->bngp', uf, bbar_im)
    bu_re = bu_re.at[:, 0].add(abar_re * s0_re - abar_im * s0_im)
    bu_im = bu_im.at[:, 0].add(abar_re * s0_im + abar_im * s0_re)
    a_re_b = jnp.broadcast_to(abar_re, bu_re.shape)
    a_im_b = jnp.broadcast_to(abar_im, bu_im.shape)
    _, _, st_re, st_im = lax.associative_scan(
        _complex_affine_combine, (a_re_b, a_im_b, bu_re, bu_im), axis=1)
    return st_re, st_im


def s5_readout(st_re, st_im, c_re, c_im, reverse):
    y = (jnp.einsum('bngp,ghp->bngh', st_re, c_re.astype(jnp.float32))
         - jnp.einsum('bngp,ghp->bngh', st_im, c_im.astype(jnp.float32)))
    if reverse:
        y = y[:, ::-1]
    return y.reshape(y.shape[0], y.shape[1], SSM_WIDTH)


def bidirectional_s5(u_lat, u_ctx, a_re, a_im, log_dt, b_re, b_im, c_re, c_im, with_ctx_out):
    bsz = u_lat.shape[0]
    zeros = jnp.zeros((bsz, N_SSM_GROUPS, SSM_STATE), jnp.float32)
    y_lat, y_ctx = [], []
    for d in range(2):
        reverse = d == 1
        disc = s5_discretise(a_re[d], a_im[d], log_dt[d], b_re[d], b_im[d])
        sc_re, sc_im = s5_states(u_ctx, zeros, zeros, *disc, reverse)
        sx_re, sx_im = s5_states(u_lat, sc_re[:, -1], sc_im[:, -1], *disc, reverse)
        y_lat.append(s5_readout(sx_re, sx_im, c_re[d], c_im[d], reverse))
        if with_ctx_out:
            y_ctx.append(s5_readout(sc_re, sc_im, c_re[d], c_im[d], reverse))
    return y_lat[0] + y_lat[1], (y_ctx[0] + y_ctx[1] if with_ctx_out else None)


def s5_output(y, u, d_skip, w_glu, b_glu):
    g = jax.nn.gelu(y + d_skip.astype(jnp.float32) * u.astype(jnp.float32)).astype(u.dtype)
    return g * jax.nn.sigmoid(g @ w_glu + b_glu)


def merge_groups(attn, ssm, gn_attn_g, gn_ssm_g, w_o):
    return jnp.concatenate([rms_norm(attn, gn_attn_g), rms_norm(ssm, gn_ssm_g)], -1) @ w_o


def hier_moe(h, w_rg, b_rg, w_re, b_re, w_gate, w_up, w_down):
    g_prob = jax.nn.softmax((h @ w_rg + b_rg).astype(jnp.float32), -1)
    g_w, g_idx = lax.top_k(g_prob, 1)
    e_logits = (h @ w_re + b_re).astype(jnp.float32).reshape(
        *h.shape[:-1], N_EXPERT_GROUPS, EXPERTS_PER_GROUP)
    g_sel = jax.nn.one_hot(g_idx[..., 0], N_EXPERT_GROUPS, dtype=jnp.float32)
    e_prob = jax.nn.softmax(jnp.einsum('...g,...ge->...e', g_sel, e_logits), -1)
    e_w, e_idx = lax.top_k(e_prob, EXPERT_TOP_K)
    e_w = e_w / jnp.sum(e_w, -1, keepdims=True) * g_w
    expert_id = g_idx * EXPERTS_PER_GROUP + e_idx
    combine = jnp.sum(jax.nn.one_hot(expert_id, N_EXPERTS, dtype=jnp.float32)
                      * e_w[..., None], axis=-2).astype(h.dtype)

    def per_sample(args):
        hs, cs = args
        a = jnp.einsum('nd,edf->nef', hs, w_gate)
        u = jnp.einsum('nd,edf->nef', hs, w_up)
        return jnp.einsum('nef,efd->nd', jax.nn.silu(a) * u * cs[..., None], w_down)

    return lax.map(per_sample, (h, combine))


def setup_inputs(seed: int = 0) -> dict:
    key = jax.random.key(seed)
    ks = iter(jax.random.split(key, 40))
    f32 = jnp.float32

    def nrm(shape, scale):
        return jax.random.normal(next(ks), shape, f32) * scale

    L, G, P = DEPTH, N_SSM_GROUPS, SSM_STATE
    n_idx = jnp.arange(P, dtype=f32)
    return {
        "x": nrm((BATCH, SEQ, D_MODEL), 1.0),
        "c": nrm((BATCH, D_MODEL), 1.0),
        "ctx": nrm((BATCH, CTX_LEN, D_MODEL), 1.0),
        "c_ctx": nrm((D_MODEL,), 1.0),
        "w_ada": nrm((L, D_MODEL, 6 * D_MODEL), 0.5 * D_MODEL ** -0.5),
        "b_ada": nrm((L, 6 * D_MODEL), 0.01),
        "w_in": nrm((L, D_MODEL, IN_PROJ_WIDTH), D_MODEL ** -0.5),
        "q_norm_g": 1.0 + nrm((L, Q_LORA_RANK), 0.01),
        "kv_norm_g": 1.0 + nrm((L, KV_LORA_RANK), 0.01),
        "w_uq": nrm((L, Q_LORA_RANK, N_HEADS * (QK_NOPE_DIM + QK_ROPE_DIM)), Q_LORA_RANK ** -0.5),
        "w_ukv": nrm((L, KV_LORA_RANK, N_HEADS * (QK_NOPE_DIM + V_HEAD_DIM)), KV_LORA_RANK ** -0.5),
        "ssm_a_re": -0.5 + nrm((L, 2, G, P), 0.01),
        "ssm_a_im": math.pi * n_idx + nrm((L, 2, G, P), 0.01),
        "ssm_log_dt": jax.random.uniform(next(ks), (L, 2, G), f32, math.log(DT_MIN), math.log(DT_MAX)),
        "ssm_b_re": nrm((L, 2, G, P, SSM_GROUP), (2 * SSM_GROUP) ** -0.5),
        "ssm_b_im": nrm((L, 2, G, P, SSM_GROUP), (2 * SSM_GROUP) ** -0.5),
        "ssm_c_re": nrm((L, 2, G, SSM_GROUP, P), (2 * P) ** -0.5),
        "ssm_c_im": nrm((L, 2, G, SSM_GROUP, P), (2 * P) ** -0.5),
        "ssm_d": nrm((L, SSM_WIDTH), 1.0),
        "w_glu": nrm((L, SSM_WIDTH, SSM_WIDTH), SSM_WIDTH ** -0.5),
        "b_glu": nrm((L, SSM_WIDTH), 0.01),
        "gn_attn_g": 1.0 + nrm((L, ATTN_WIDTH), 0.01),
        "gn_ssm_g": 1.0 + nrm((L, SSM_WIDTH), 0.01),
        "w_o": nrm((L, MIX_WIDTH, D_MODEL), MIX_WIDTH ** -0.5 * BETA),
        "ln1_g": 1.0 + nrm((L, D_MODEL), 0.01),
        "ln1_b": nrm((L, D_MODEL), 0.01),
        "w_router_group": nrm((L, D_MODEL, N_EXPERT_GROUPS), D_MODEL ** -0.5),
        "b_router_group": nrm((L, N_EXPERT_GROUPS), 0.01),
        "w_router_expert": nrm((L, D_MODEL, N_EXPERTS), D_MODEL ** -0.5),
        "b_router_expert": nrm((L, N_EXPERTS), 0.01),
        "w_exp_gate": nrm((L, N_EXPERTS, D_MODEL, D_FF_EXPERT), D_MODEL ** -0.5),
        "w_exp_up": nrm((L, N_EXPERTS, D_MODEL, D_FF_EXPERT), D_MODEL ** -0.5),
        "w_exp_down": nrm((L, N_EXPERTS, D_FF_EXPERT, D_MODEL), D_FF_EXPERT ** -0.5 * BETA),
        "ln2_g": 1.0 + nrm((L, D_MODEL), 0.01),
        "ln2_b": nrm((L, D_MODEL), 0.01),
    }


def reference(x, c, ctx, c_ctx, w_ada, b_ada, w_in, q_norm_g, kv_norm_g, w_uq, w_ukv,
              ssm_a_re, ssm_a_im, ssm_log_dt, ssm_b_re, ssm_b_im, ssm_c_re, ssm_c_im, ssm_d,
              w_glu, b_glu, gn_attn_g, gn_ssm_g, w_o, ln1_g, ln1_b,
              w_router_group, b_router_group, w_router_expert, b_router_expert,
              w_exp_gate, w_exp_up, w_exp_down, ln2_g, ln2_b):
    n_lat = x.shape[1]
    rope = axial_rope_tables(n_lat)
    silu_c = jax.nn.silu(c)
    silu_cc = jax.nn.silu(c_ctx)
    for l in range(DEPTH):
        last = l == DEPTH - 1
        mod_x = (silu_c @ w_ada[l] + b_ada[l])[:, None, :]
        mod_c = silu_cc @ w_ada[l] + b_ada[l]
        sh_a_x, sc_a_x, g_a_x, sh_f_x, sc_f_x, g_f_x = jnp.split(mod_x, 6, -1)
        sh_a_c, sc_a_c, g_a_c, sh_f_c, sc_f_c, g_f_c = jnp.split(mod_c, 6, -1)

        p_x = modulate(x, sh_a_x, sc_a_x) @ w_in[l]
        p_c = modulate(ctx, sh_a_c, sc_a_c) @ w_in[l]
        qx_n, qx_r, kx_n, kx_r, vx = mla_project(p_x[..., :MLA_IN_WIDTH], q_norm_g[l], kv_norm_g[l],
                                                 w_uq[l], w_ukv[l], rope)
        qc_n, qc_r, kc_n, kc_r, vc = mla_project(p_c[..., :MLA_IN_WIDTH], q_norm_g[l], kv_norm_g[l],
                                                 w_uq[l], w_ukv[l], None)
        attn_x = latent_attention(qx_n, qx_r,
                                  jnp.concatenate([kx_n, kc_n], 1),
                                  jnp.concatenate([kx_r, kc_r], 1),
                                  jnp.concatenate([vx, vc], 1))
        u_x, u_c = p_x[..., MLA_IN_WIDTH:], p_c[..., MLA_IN_WIDTH:]
        y_x, y_c = bidirectional_s5(u_x, u_c, ssm_a_re[l], ssm_a_im[l], ssm_log_dt[l],
                                    ssm_b_re[l], ssm_b_im[l], ssm_c_re[l], ssm_c_im[l],
                                    with_ctx_out=not last)
        ssm_x = s5_output(y_x, u_x, ssm_d[l], w_glu[l], b_glu[l])
        mix_x = merge_groups(attn_x, ssm_x, gn_attn_g[l], gn_ssm_g[l], w_o[l])
        x = layer_norm(ALPHA * x + g_a_x * mix_x, ln1_g[l], ln1_b[l])
        if not last:
            attn_c = mla_attend(qc_n, qc_r, kc_n, kc_r, vc).reshape(*ctx.shape[:2], ATTN_WIDTH)
            ssm_c = s5_output(y_c, u_c, ssm_d[l], w_glu[l], b_glu[l])
            mix_c = merge_groups(attn_c, ssm_c, gn_attn_g[l], gn_ssm_g[l], w_o[l])
            ctx = layer_norm(ALPHA * ctx + g_a_c * mix_c, ln1_g[l], ln1_b[l])

        ffn_x = hier_moe(modulate(x, sh_f_x, sc_f_x), w_router_group[l], b_router_group[l],
                         w_router_expert[l], b_router_expert[l],
                         w_exp_gate[l], w_exp_up[l], w_exp_down[l])
        x = layer_norm(ALPHA * x + g_f_x * ffn_x, ln2_g[l], ln2_b[l])
        if not last:
            ffn_c = hier_moe(modulate(ctx, sh_f_c, sc_f_c), w_router_group[l], b_router_group[l],
                             w_router_expert[l], b_router_expert[l],
                             w_exp_gate[l], w_exp_up[l], w_exp_down[l])
            ctx = layer_norm(ALPHA * ctx + g_f_c * ffn_c, ln2_g[l], ln2_b[l])
    return x
```

```cpp
#include <hip/hip_runtime.h>
#include <cstdio>
#include <cstdint>

#ifndef DEBUG_CHECK
#define DEBUG_CHECK 0
#endif
#ifndef LAST_STAGE
#define LAST_STAGE 99
#endif
#ifndef POISON_WS
#define POISON_WS 0
#endif

#define LAS __attribute__((address_space(3)))
#define DI __device__ __forceinline__
typedef unsigned short bf16_t;
typedef short bf16x8 __attribute__((ext_vector_type(8)));
typedef float f32x16 __attribute__((ext_vector_type(16)));
typedef float f32x4 __attribute__((ext_vector_type(4)));
typedef float f32x2 __attribute__((ext_vector_type(2)));
typedef __bf16 bf16x2n __attribute__((ext_vector_type(2)));
typedef unsigned u32x4 __attribute__((ext_vector_type(4)));
typedef unsigned u32x2 __attribute__((ext_vector_type(2)));

constexpr int NT = 512;
constexpr int LDS_BYTES = 147456;
constexpr int LDS_MISC = LDS_BYTES - 64;

constexpr int DM = 1024, NB = 4, SEQ = 4096, CTXL = 256, NH = 8;
constexpr int MLAT = NB * SEQ, MCTX = NB * CTXL, MALL = MLAT + MCTX;
constexpr int NKEY = SEQ + CTXL;
constexpr int NUNIT_B = NKEY / 16, NUNIT = NB * NUNIT_B;
constexpr float EPS = 1e-6f;
constexpr float ALPHA = 1.189207115002721f;
constexpr float QSCALE = 0.10206207261596577f * 1.4426950408889634f;

enum { I_X = 0, I_C, I_CTX, I_CCTX, I_WADA, I_BADA, I_WIN, I_QNG, I_KVNG, I_WUQ, I_WUKV, I_ARE, I_AIM, I_LOGDT, I_BRE, I_BIM, I_CRE, I_CIM,
       I_SSMD, I_WGLU, I_BGLU, I_GNA, I_GNS, I_WO, I_LN1G, I_LN1B, I_WRG, I_BRG, I_WRE, I_BRE2, I_WEG, I_WEU, I_WED, I_LN2G, I_LN2B, N_IN };

constexpr size_t MiB = 1u << 20;
constexpr size_t WS_CTL = 0;
constexpr size_t WS_MODP = 1 * MiB;
constexpr size_t WS_MOD = WS_MODP + 16 * 5 * 6144 * 4;
constexpr size_t WS_ROPEC = WS_MOD + 5 * 6144 * 4;
constexpr size_t WS_ROPES = WS_ROPEC + 4096 * 16 * 4;
constexpr size_t WS_PW = WS_ROPES + 4096 * 16 * 4;
constexpr size_t WS_BBAR = WS_PW + 64 * 64 * 20 * 8;
constexpr size_t WS_KC = WS_BBAR + 64 * 64 * 16 * 8;
constexpr size_t WS_WRT = WS_KC + 64 * 16 * 256 * 4;
constexpr size_t WS_TOKW = WS_WRT + 40 * 1024 * 4;
constexpr size_t WS_LIST = WS_TOKW + 16384 * 2 * 4;
constexpr size_t WS_SMALL_END = WS_LIST + 32 * 16384 * 4;
static_assert(WS_SMALL_END <= 9 * MiB, "small region");
constexpr size_t WS_WTIN = 9 * MiB;
constexpr size_t WS_WTO = 11 * MiB;
constexpr size_t WS_WTUQ = 13 * MiB;
constexpr size_t WS_WTUKV = WS_WTUQ + 768 * 256 * 2;
constexpr size_t WS_WTGLU = WS_WTUKV + 1024 * 128 * 2;
static_assert(WS_WTGLU + 512 * 512 * 2 <= 15 * MiB, "w region");
constexpr size_t WS_WEXP = 15 * MiB;
constexpr size_t WS_WGU = WS_WEXP, WS_WD = WS_WEXP + 32 * MiB;
constexpr size_t WS_M16 = 15 * MiB;
constexpr size_t WS_W3 = 19 * MiB;
constexpr size_t WS_ST = 27 * MiB;
constexpr size_t WS_XM = 63 * MiB;
constexpr size_t WS_P = 97 * MiB;
constexpr size_t WS_Q = 131 * MiB;
constexpr size_t WS_K = 155 * MiB;
constexpr size_t WS_VT = 181 * MiB;
constexpr size_t WS_G = 198 * MiB;
constexpr size_t WS_MIX = 214 * MiB;
constexpr size_t WS_H = 63 * MiB;
constexpr size_t WS_Z = 97 * MiB;
constexpr size_t WS_F = 113 * MiB;
static_assert(WS_MIX + 32 * MiB <= 256 * MiB && WS_F + 64 * MiB <= WS_VT, "ws map");
constexpr int CW_CHK = 16, CW_CNT = 64  , CW_BAR = 4096;

struct Params { const float* in[N_IN]; float* out; unsigned char* ws; };

#define XB_TMO      128
#define XB_XCNT(j)  (256  + 64 * (j))
#define XB_XSUB(j)  (1280 + 64 * (j))
#define XB_XGEN(j)  (2304 + 64 * (j))
#define XB_TOP      3328
#define XB_TOPGEN   3392
#define XCD_BAR_WORDS 3456
#define XB_SPIN_CAP (1u << 18)
DI unsigned xb_ld(unsigned* p)              { return __hip_atomic_load(p, __ATOMIC_RELAXED, __HIP_MEMORY_SCOPE_AGENT); }
DI unsigned xb_add(unsigned* p, unsigned v) { return __hip_atomic_fetch_add(p, v, __ATOMIC_RELAXED, __HIP_MEMORY_SCOPE_AGENT); }
DI unsigned xb_xcc_id() { return (unsigned)__builtin_amdgcn_s_getreg((3 << 11) | 20) & 0xFu; }
#define XB_SPIN(cond, bar) do { unsigned _sp = 0; while (cond) { __builtin_amdgcn_s_sleep(1); \
    if ((++_sp & 255u) == 0u) { if (xb_ld(&(bar)[XB_TMO])) break; if (_sp > XB_SPIN_CAP) { atomicAdd(&(bar)[XB_TMO], 1u); break; } } } } while (0)
struct XcdBarrier { unsigned* bar; unsigned x; volatile LAS unsigned* st; };
DI XcdBarrier xcd_barrier_post(unsigned* bar, volatile LAS unsigned* st) {
    XcdBarrier b; b.bar = bar; b.x = xb_xcc_id(); b.st = st;
    if (threadIdx.x == 0) (void)xb_add(&bar[XB_XCNT(b.x)], 1u);
    return b;
}
DI void xcd_barrier_complete(unsigned* bar, unsigned x, unsigned& nloc, unsigned& nx) {
    const unsigned G = gridDim.x * gridDim.y * gridDim.z;
    unsigned sum, cnt, mine, sp = 0u;
    for (;;) {
        sum = 0u; cnt = 0u; mine = 0u;
#pragma unroll
        for (unsigned j = 0; j < 16; ++j) { const unsigned c = xb_ld(&bar[XB_XCNT(j)]); sum += c; cnt += (c > 0u) ? 1u : 0u; mine = (j == x) ? c : mine; }
        if (sum == G) break;
        __builtin_amdgcn_s_sleep(1);
        if ((++sp & 255u) == 0u) { if (xb_ld(&bar[XB_TMO])) break; if (sp > XB_SPIN_CAP) { atomicAdd(&bar[XB_TMO], 1u); break; } }
    }
    nloc = mine > 0u ? mine : 1u; nx = cnt > 0u ? cnt : 1u;
}
DI void xcd_barrier(const XcdBarrier& b) {
    asm volatile("s_waitcnt vmcnt(0)" ::: "memory");
    __syncthreads();
    if (threadIdx.x == 0) {
        unsigned* bar = b.bar;
        __builtin_amdgcn_s_waitcnt(0);
        unsigned nloc = b.st[0], nx = b.st[1];
        if (nloc == 0u) { xcd_barrier_complete(bar, b.x, nloc, nx); b.st[0] = nloc; b.st[1] = nx; }
        const unsigned old = xb_add(&bar[XB_XSUB(b.x)], 1u);
        const unsigned gen = old / nloc;
        if (old + 1u == (gen + 1u) * nloc) {
            __builtin_amdgcn_fence(__ATOMIC_RELEASE, "agent");
            asm volatile("s_waitcnt vmcnt(0)" ::: "memory");
            const unsigned og = xb_add(&bar[XB_TOP], 1u);
            const unsigned tg = og / nx;
            if (og + 1u == (tg + 1u) * nx) xb_add(&bar[XB_TOPGEN], 1u);
            else XB_SPIN(xb_ld(&bar[XB_TOPGEN]) == tg, bar);
            __builtin_amdgcn_fence(__ATOMIC_ACQUIRE, "agent");
            xb_add(&bar[XB_XGEN(b.x)], 1u);
            asm volatile("s_waitcnt vmcnt(0)" ::: "memory");
        } else {
            XB_SPIN(xb_ld(&bar[XB_XGEN(b.x)]) == gen, bar);
            __builtin_amdgcn_fence(__ATOMIC_ACQUIRE, "agent");
            asm volatile("s_waitcnt vmcnt(0)" ::: "memory");
        }
    }
    __syncthreads();
}

DI float bf2f(bf16_t u) { return __uint_as_float((unsigned)u << 16); }
DI bf16_t f2bf(float f) { unsigned u = __float_as_uint(f); return (bf16_t)((u + 0x7fffu + ((u >> 16) & 1u)) >> 16); }
DI unsigned pk2(float lo, float hi) { f32x2 v = {lo, hi}; bf16x2n r = __builtin_convertvector(v, bf16x2n); return __builtin_bit_cast(unsigned, r); }
DI float lo16(unsigned u) { return __uint_as_float(u << 16); }
DI float hi16(unsigned u) { return __uint_as_float(u & 0xffff0000u); }
DI float wave_sum(float v) {
#pragma unroll
    for (int o = 1; o < 64; o <<= 1) v += __shfl_xor(v, o);
    return v;
}
DI float sigmoidf_(float x) { return 1.f / (1.f + __expf(-x)); }
DI float siluf_(float x) { return x * sigmoidf_(x); }
DI float geluf_(float x) { const float z = 0.7978845608028654f * (x + 0.044715f * x * x * x); const float t = 1.f - 2.f / (__expf(2.f * z) + 1.f); return 0.5f * x * (1.f + t); }
DI int keypos(int key) { const int o = key & 15; return (key & ~15) | ((o & 3) + 4 * ((o >> 3) & 1) + 8 * ((o >> 2) & 1)); }
DI int unit_row0(int u) { const int b = u / NUNIT_B, c = u % NUNIT_B; return c < 16 ? MLAT + b * CTXL + 16 * c : b * SEQ + 16 * (c - 16); }

struct Ctx {
    Params p; LAS unsigned char* lds; int tid, lane, wid, bid, G;
    DI const float* in(int i) const { return p.in[i]; }
    template <class T> DI T* ws(size_t off) const { return (T*)(p.ws + off); }
};

constexpr int GBM = 256, GBN = 128, GROW = 144, G_ASTAGE = GBM * GROW, G_WSTAGE = GBN * GROW, G_STAGE = G_ASTAGE + G_WSTAGE;
constexpr int G_SCR = 2 * G_STAGE;
#define MFMA32(a, b, c) __builtin_amdgcn_mfma_f32_32x32x16_bf16((a), (b), (c), 0, 0, 0)

template <class AL, class WL, class EPI>
DI void gemm_tile(const Ctx& c, AL& al, WL& wl, int m0, int n0, int K, EPI& epi, const LAS float* midscale, int midk) {
    const int lane = c.lane, wid = c.wid, r = lane & 31, h = lane >> 5, wm = wid & 3, wn = wid >> 2;
    const int lrow = c.tid >> 3, lkc = c.tid & 7;
    f32x16 acc[2][2];
#pragma unroll
    for (int i = 0; i < 2; ++i)
#pragma unroll
        for (int j = 0; j < 2; ++j)
#pragma unroll
            for (int e = 0; e < 16; ++e) acc[i][j][e] = 0.f;
#pragma unroll
    for (int i = 0; i < 4; ++i) al.init(i, m0 + lrow + 64 * i);
#pragma unroll
    for (int i = 0; i < 2; ++i) wl.init(i, n0 + lrow + 64 * i);
    u32x4 ra[4], rw[2];
    const int nk = K / 64;
#pragma unroll
    for (int i = 0; i < 4; ++i) ra[i] = al.load(i, lkc * 8);
#pragma unroll
    for (int i = 0; i < 2; ++i) rw[i] = wl.load(i, lkc * 8);
    {
        LAS unsigned char* base = c.lds;
#pragma unroll
        for (int i = 0; i < 4; ++i) *(LAS u32x4*)(base + (lrow + 64 * i) * GROW + lkc * 16) = ra[i];
#pragma unroll
        for (int i = 0; i < 2; ++i) *(LAS u32x4*)(base + G_ASTAGE + (lrow + 64 * i) * GROW + lkc * 16) = rw[i];
    }
    __syncthreads();
    for (int kt = 0; kt < nk; ++kt) {
        const int buf = kt & 1;
        if (kt + 1 < nk) {
#pragma unroll
            for (int i = 0; i < 4; ++i) ra[i] = al.load(i, (kt + 1) * 64 + lkc * 8);
#pragma unroll
            for (int i = 0; i < 2; ++i) rw[i] = wl.load(i, (kt + 1) * 64 + lkc * 8);
        }
        const LAS unsigned char* sa = c.lds + buf * G_STAGE + (wm * 64 + r) * GROW + h * 16;
        const LAS unsigned char* sw = c.lds + buf * G_STAGE + G_ASTAGE + (wn * 64 + r) * GROW + h * 16;
#pragma unroll
        for (int ks = 0; ks < 4; ++ks) {
            const bf16x8 a0 = *(const LAS bf16x8*)(sa + ks * 32), a1 = *(const LAS bf16x8*)(sa + 32 * GROW + ks * 32);
            const bf16x8 w0 = *(const LAS bf16x8*)(sw + ks * 32), w1 = *(const LAS bf16x8*)(sw + 32 * GROW + ks * 32);
            acc[0][0] = MFMA32(w0, a0, acc[0][0]); acc[0][1] = MFMA32(w0, a1, acc[0][1]);
            acc[1][0] = MFMA32(w1, a0, acc[1][0]); acc[1][1] = MFMA32(w1, a1, acc[1][1]);
        }
        if (midscale != nullptr && kt == midk) {
            const float s0 = midscale[wm * 64 + r], s1 = midscale[wm * 64 + 32 + r];
#pragma unroll
            for (int e = 0; e < 16; ++e) { acc[0][0][e] *= s0; acc[1][0][e] *= s0; acc[0][1][e] *= s1; acc[1][1][e] *= s1; }
        }
        if (kt + 1 < nk) {
            LAS unsigned char* base = c.lds + (buf ^ 1) * G_STAGE;
#pragma unroll
            for (int i = 0; i < 4; ++i) *(LAS u32x4*)(base + (lrow + 64 * i) * GROW + lkc * 16) = ra[i];
#pragma unroll
            for (int i = 0; i < 2; ++i) *(LAS u32x4*)(base + G_ASTAGE + (lrow + 64 * i) * GROW + lkc * 16) = rw[i];
        }
        __syncthreads();
    }
    epi.run(acc, m0 + wm * 64 + r, n0 + wn * 64, h, wm * 64 + r);
}

template <int NR> struct RowLoader {
    const bf16_t* base; int ld, nrows; const bf16_t* rp[NR];
    DI void init(int i, int row) { rp[i] = base + (size_t)(row < nrows ? row : nrows - 1) * ld; }
    DI u32x4 load(int i, int k) const { return *(const u32x4*)(rp[i] + k); }
};

DI int maprow(int mode, int j) {
    if (mode == 1) return j < 416 ? j : j + 96;
    if (mode == 2) return 64 * (j >> 5) + (j & 31);
    if (mode == 3) return 64 * (j >> 5) + 32 + (j & 31);
    return j;
}
DI void tr_tile(const Ctx& c, const float* src, int ldsrc, int k0, int j0, bf16_t* dst, int lddst, int mode, const float* gain) {
    LAS float* scr = (LAS float*)c.lds;
    __syncthreads();
    {
        const int jj = c.tid & 63;
        const bool ok = (j0 + jj) < ldsrc;
#pragma unroll
        for (int i = 0; i < 8; ++i) {
            const int kk = i * 8 + (c.tid >> 6);
            float v = ok ? src[(size_t)(k0 + kk) * ldsrc + j0 + jj] : 0.f;
            if (gain) v *= gain[k0 + kk];
            scr[kk * 65 + jj] = v;
        }
    }
    __syncthreads();
    {
        const int jj = c.tid >> 3, kc = c.tid & 7;
        if (j0 + jj < ldsrc) {
            const LAS float* s = scr + (kc * 8) * 65 + jj;
            u32x4 o; o.x = pk2(s[0], s[65]); o.y = pk2(s[2 * 65], s[3 * 65]); o.z = pk2(s[4 * 65], s[5 * 65]); o.w = pk2(s[6 * 65], s[7 * 65]);
            *(u32x4*)(dst + (size_t)maprow(mode, j0 + jj) * lddst + k0 + kc * 8) = o;
        }
    }
}

DI void stage_prep(const Ctx& c) {
    constexpr int N_MODP = 16 * 12, N_ROPE = 128, N_SSM0 = 8, N_WIN = 16 * 15, N_WO = 256, N_WUQ = 4 * 12, N_WUKV = 2 * 16, N_WGLU = 64, N_MISC = 1;
    constexpr int TOT = N_MODP + N_ROPE + N_SSM0 + N_WIN + N_WO + N_WUQ + N_WUKV + N_WGLU + N_MISC;
    for (int it0 = c.bid; it0 < TOT; it0 += c.G) {
        int it = it0;
        if (it < N_MODP) {
            const int kc = it / 12, jb = it % 12;
            LAS float* sv = (LAS float*)c.lds;
            __syncthreads();
            if (c.tid < 320) { const int r = c.tid / 64, k = kc * 64 + (c.tid & 63); const float v = r < 4 ? c.in(I_C)[r * 1024 + k] : c.in(I_CCTX)[k]; sv[c.tid] = siluf_(v); }
            __syncthreads();
            const int j = jb * 512 + c.tid;
            float a0 = 0.f, a1 = 0.f, a2 = 0.f, a3 = 0.f, a4 = 0.f;
            const float* w = c.in(I_WADA) + (size_t)(kc * 64) * 6144 + j;
#pragma unroll 8
            for (int k = 0; k < 64; ++k) { const float wv = w[(size_t)k * 6144]; a0 += sv[k] * wv; a1 += sv[64 + k] * wv; a2 += sv[128 + k] * wv; a3 += sv[192 + k] * wv; a4 += sv[256 + k] * wv; }
            float* mp = c.ws<float>(WS_MODP) + (size_t)kc * 5 * 6144 + j;
            mp[0] = a0; mp[6144] = a1; mp[2 * 6144] = a2; mp[3 * 6144] = a3; mp[4 * 6144] = a4;
            continue;
        }
        it -= N_MODP;
        if (it < N_ROPE) {
            const int idx = it * 512 + c.tid, t = idx >> 4, i = idx & 15;
            const int pos = (i < 8) ? (t >> 6) : (t & 63);
            const double inv = exp2(-(double)(i & 7) * (13.287712379549449 / 8.0));
            const double ang = (double)pos * inv;
            c.ws<float>(WS_ROPEC)[idx] = (float)cos(ang); c.ws<float>(WS_ROPES)[idx] = (float)sin(ang);
            continue;
        }
        it -= N_ROPE;
        if (it < N_SSM0) {
            const int idx = it * 512 + c.tid, dg = idx >> 6, p = idx & 63;
            const double are = c.in(I_ARE)[idx], aim = c.in(I_AIM)[idx], dt = exp((double)c.in(I_LOGDT)[dg]);
            float2* pw = c.ws<float2>(WS_PW) + (size_t)idx * 20;
            for (int k = 0; k <= 16; ++k) { const double mag = exp(are * dt * k), ang = aim * dt * k; pw[k] = make_float2((float)(mag * cos(ang)), (float)(mag * sin(ang))); }
            const double mag = exp(are * dt), abr = mag * cos(aim * dt), abi = mag * sin(aim * dt);
            const double den = are * are + aim * aim, nre = abr - 1.0;
            const double cre = (nre * are + abi * aim) / den, cim = (abi * are - nre * aim) / den;
            float2* bb = c.ws<float2>(WS_BBAR) + (size_t)idx * 16;
            for (int hh = 0; hh < 16; ++hh) { const double br = c.in(I_BRE)[(size_t)idx * 16 + hh], bi = c.in(I_BIM)[(size_t)idx * 16 + hh];
                bb[hh] = make_float2((float)(cre * br - cim * bi), (float)(cre * bi + cim * br)); }
            continue;
        }
        it -= N_SSM0;
        if (it < N_WIN) { const int kb = it / 15, jb = it % 15; tr_tile(c, c.in(I_WIN), 928, kb * 64, jb * 64, c.ws<bf16_t>(WS_WTIN), 1024, 1, nullptr); continue; }
        it -= N_WIN;
        if (it < N_WO) { const int kb = it / 16, jb = it % 16; tr_tile(c, c.in(I_WO), 1024, kb * 64, jb * 64, c.ws<bf16_t>(WS_WTO), 1024, 0, kb < 8 ? c.in(I_GNA) : c.in(I_GNS) - 512); continue; }
        it -= N_WO;
        if (it < N_WUQ) { const int kb = it / 12, jb = it % 12; tr_tile(c, c.in(I_WUQ), 768, kb * 64, jb * 64, c.ws<bf16_t>(WS_WTUQ), 256, 0, c.in(I_QNG)); continue; }
        it -= N_WUQ;
        if (it < N_WUKV) { const int kb = it / 16, jb = it % 16; tr_tile(c, c.in(I_WUKV), 1024, kb * 64, jb * 64, c.ws<bf16_t>(WS_WTUKV), 128, 0, c.in(I_KVNG)); continue; }
        it -= N_WUKV;
        if (it < N_WGLU) { const int kb = it / 8, jb = it % 8; tr_tile(c, c.in(I_WGLU), 512, kb * 64, jb * 64, c.ws<bf16_t>(WS_WTGLU), 512, 0, nullptr); continue; }
        it -= N_WGLU;
        {
            bf16_t* wt = c.ws<bf16_t>(WS_WTIN);
            for (int i = c.tid; i < 96 * 1024 / 8; i += NT) ((u32x4*)(wt + 416 * 1024))[i] = (u32x4){0u, 0u, 0u, 0u};
            float* wr = c.ws<float>(WS_WRT);
            for (int i = c.tid; i < 36 * 1024; i += NT) { const int e = i >> 10, k = i & 1023; wr[i] = e < 4 ? c.in(I_WRG)[k * 4 + e] : c.in(I_WRE)[k * 32 + (e - 4)]; }
        }
    }
}

DI void stage_s1(const Ctx& c) {
    const int gt = c.bid * NT + c.tid, GT = c.G * NT;
    for (int i = gt; i < 5 * 6144; i += GT) {
        const int j = i % 6144; float s = c.in(I_BADA)[j];
#pragma unroll
        for (int kc = 0; kc < 16; ++kc) s += c.ws<float>(WS_MODP)[(size_t)kc * 5 * 6144 + i];
        c.ws<float>(WS_MOD)[i] = s;
    }
    const float2* pw = c.ws<float2>(WS_PW); const float2* bbar = c.ws<float2>(WS_BBAR);
    for (int i = gt; i < 32 * 256 * 256; i += GT) {
        const int k = i & 255, n = (i >> 8) & 255, g = i >> 16;
        const int d = n >> 7, ri = (n >> 6) & 1, p = n & 63, j = k >> 4, hp = k & 15;
        const int dg = d * 32 + g, e = d ? j : 15 - j;
        const float2 a = pw[(size_t)(dg * 64 + p) * 20 + e], b = bbar[(size_t)(dg * 64 + p) * 16 + hp];
        const float v = ri ? (a.x * b.y + a.y * b.x) : (a.x * b.x - a.y * b.y);
        c.ws<bf16_t>(WS_M16)[i] = f2bf(v);
    }
    for (int i = gt; i < 64 * 16 * 256; i += GT) {
        const int hp = i & 15, hh = (i >> 4) & 15, lag = (i >> 8) & 15, dg = i >> 12;
        const float* cre = c.in(I_CRE) + (size_t)(dg * 16 + hh) * 64; const float* cim = c.in(I_CIM) + (size_t)(dg * 16 + hh) * 64;
        float s = 0.f;
        for (int p = 0; p < 64; ++p) {
            const float2 a = pw[(size_t)(dg * 64 + p) * 20 + lag], b = bbar[(size_t)(dg * 64 + p) * 16 + hp];
            const float tr = a.x * b.x - a.y * b.y, ti = a.x * b.y + a.y * b.x;
            s += cre[p] * tr - cim[p] * ti;
        }
        c.ws<float>(WS_KC)[i] = s;
    }
}

DI void stage_s2(const Ctx& c) {
    const float* mod = c.ws<float>(WS_MOD);
    for (int row = c.bid * 8 + c.wid; row < MALL; row += c.G * 8) {
        const int mr = row < MLAT ? row / SEQ : 4;
        const float* src = row < MLAT ? c.in(I_X) + (size_t)row * 1024 : c.in(I_CTX) + (size_t)(row - MLAT) * 1024;
        const float* sh = mod + (size_t)mr * 6144, * sc = sh + 1024;
        bf16_t* dst = c.ws<bf16_t>(WS_XM) + (size_t)row * 1024;
#pragma unroll
        for (int j = 0; j < 4; ++j) {
            const int n = (c.lane + 64 * j) * 4;
            const f32x4 v = *(const f32x4*)(src + n), a = *(const f32x4*)(sc + n), b = *(const f32x4*)(sh + n);
            u32x2 o; o.x = pk2(v.x * (1.f + a.x) + b.x, v.y * (1.f + a.y) + b.y); o.y = pk2(v.z * (1.f + a.z) + b.z, v.w * (1.f + a.w) + b.w);
            *(u32x2*)(dst + n) = o;
        }
    }
    const int gt = c.bid * NT + c.tid, GT = c.G * NT;
    const float2* pw = c.ws<float2>(WS_PW); const float* kc = c.ws<float>(WS_KC);
    for (int idx = gt; idx < 32 * 256 * 512; idx += GT) {
        const int k = idx & 511, n = (idx >> 9) & 255, g = idx >> 17, i = n >> 4, hh = n & 15;
        float v;
        if (k < 256) {
            const int d = k >> 7, ri = (k >> 6) & 1, p = k & 63, dg = d * 32 + g, e = d ? 16 - i : i + 1;
            const float2 a = pw[(size_t)(dg * 64 + p) * 20 + e];
            const float cr = c.in(I_CRE)[(size_t)(dg * 16 + hh) * 64 + p], ci = c.in(I_CIM)[(size_t)(dg * 16 + hh) * 64 + p];
            v = ri ? -(cr * a.y + ci * a.x) : (cr * a.x - ci * a.y);
        } else {
            const int j = (k - 256) >> 4, hp = (k - 256) & 15;
            v = 0.f;
            if (j <= i) v += kc[(size_t)((0 * 32 + g) * 16 + (i - j)) * 256 + hh * 16 + hp];
            if (j >= i) v += kc[(size_t)((1 * 32 + g) * 16 + (j - i)) * 256 + hh * 16 + hp];
            if (j == i && hp == hh) v += c.in(I_SSMD)[g * 16 + hh];
        }
        c.ws<bf16_t>(WS_W3)[idx] = f2bf(v);
    }
}

struct EpiStoreBf16 {
    bf16_t* O; int ld, nrows;
    DI void run(const f32x16 (&acc)[2][2], int mbase, int nb0, int h, int) const {
#pragma unroll
        for (int im = 0; im < 2; ++im) { const int m = mbase + im * 32; if (m >= nrows) continue;
#pragma unroll
            for (int in = 0; in < 2; ++in)
#pragma unroll
                for (int g = 0; g < 4; ++g) { const int n = nb0 + in * 32 + 8 * g + 4 * h; const f32x16& v = acc[in][im];
                    u32x2 o; o.x = pk2(v[4 * g], v[4 * g + 1]); o.y = pk2(v[4 * g + 2], v[4 * g + 3]); *(u32x2*)(O + (size_t)m * ld + n) = o; } }
    }
};
DI void stage_inproj(const Ctx& c) {
    constexpr int NMT = MALL / 256, NNT = 8;
    for (int it = c.bid; it < NMT * NNT; it += c.G) {
        const int mt = it / NNT, nt = it % NNT;
        RowLoader<4> al; al.base = c.ws<bf16_t>(WS_XM); al.ld = 1024; al.nrows = MALL;
        RowLoader<2> wl; wl.base = c.ws<bf16_t>(WS_WTIN); wl.ld = 1024; wl.nrows = 1024;
        EpiStoreBf16 epi{c.ws<bf16_t>(WS_P), 1024, MALL};
        gemm_tile(c, al, wl, mt * 256, nt * 128, 1024, epi, nullptr, -1);
    }
}

struct EpiQ {
    bf16_t* Q; const LAS float* rs; const float* ropec; const float* ropes;
    DI void run(const f32x16 (&acc)[2][2], int mbase, int nb0, int h, int lrow) const {
#pragma unroll
        for (int im = 0; im < 2; ++im) {
            const int m = mbase + im * 32, b = m >> 12, t = m & 4095; const float rq = rs[lrow + im * 32] * QSCALE;
#pragma unroll
            for (int in = 0; in < 2; ++in) {
                const int nb = nb0 + in * 32, head = nb / 96, db = nb % 96; const f32x16& v = acc[in][im];
                bf16_t* q = Q + ((size_t)(b * NH + head) * SEQ + t) * 96;
                if (db < 64) {
#pragma unroll
                    for (int g = 0; g < 4; ++g) { u32x2 o; o.x = pk2(v[4 * g] * rq, v[4 * g + 1] * rq); o.y = pk2(v[4 * g + 2] * rq, v[4 * g + 3] * rq); *(u32x2*)(q + db + 8 * g + 4 * h) = o; }
                } else {
#pragma unroll
                    for (int g = 0; g < 2; ++g) {
                        const int i = 8 * g + 4 * h;
                        const f32x4 cs = *(const f32x4*)(ropec + t * 16 + i), sn = *(const f32x4*)(ropes + t * 16 + i);
                        float o1[4], o2[4];
#pragma unroll
                        for (int e = 0; e < 4; ++e) { const float t1 = v[4 * g + e] * rq, t2 = v[4 * (g + 2) + e] * rq; o1[e] = t1 * cs[e] - t2 * sn[e]; o2[e] = t2 * cs[e] + t1 * sn[e]; }
                        u32x2 a; a.x = pk2(o1[0], o1[1]); a.y = pk2(o1[2], o1[3]); *(u32x2*)(q + 64 + i) = a;
                        u32x2 bq; bq.x = pk2(o2[0], o2[1]); bq.y = pk2(o2[2], o2[3]); *(u32x2*)(q + 80 + i) = bq;
                    }
                }
            }
        }
    }
};
struct EpiKV {
    bf16_t* Kb; bf16_t* Vt; const LAS float* rs;
    DI void run(const f32x16 (&acc)[2][2], int mbase, int nb0, int h, int lrow) const {
#pragma unroll
        for (int im = 0; im < 2; ++im) {
            const int m = mbase + im * 32; if (m >= MALL) continue;
            int b, key; if (m < MLAT) { b = m >> 12; key = m & 4095; } else { b = (m - MLAT) >> 8; key = SEQ + ((m - MLAT) & 255); }
            const float rk = rs[lrow + im * 32];
#pragma unroll
            for (int in = 0; in < 2; ++in) {
                const int nb = nb0 + in * 32, head = nb >> 7, db = nb & 127; const f32x16& v = acc[in][im];
                if (db < 64) {
                    bf16_t* kp = Kb + ((size_t)(b * NH + head) * NKEY + key) * 96 + db;
#pragma unroll
                    for (int g = 0; g < 4; ++g) { u32x2 o; o.x = pk2(v[4 * g] * rk, v[4 * g + 1] * rk); o.y = pk2(v[4 * g + 2] * rk, v[4 * g + 3] * rk); *(u32x2*)(kp + 8 * g + 4 * h) = o; }
                } else {
                    bf16_t* vp = Vt + ((size_t)(b * NH + head) * 64 + (db - 64)) * NKEY + keypos(key);
#pragma unroll
                    for (int g = 0; g < 4; ++g)
#pragma unroll
                        for (int e = 0; e < 4; ++e) vp[(size_t)(8 * g + 4 * h + e) * NKEY] = f2bf(v[4 * g + e] * rk);
                }
            }
        }
    }
};
struct UcLoader {
    const bf16_t* P; int g; const bf16_t* rp[4];
    DI void init(int i, int u) { rp[i] = P + (size_t)unit_row0(u < NUNIT ? u : NUNIT - 1) * 1024 + 512 + 16 * g; }
    DI u32x4 load(int i, int k) const { return *(const u32x4*)(rp[i] + (k >> 4) * 1024 + (k & 15)); }
};
struct EpiST {
    bf16_t* ST; int g;
    DI void run(const f32x16 (&acc)[2][2], int mbase, int nb0, int h, int) const {
#pragma unroll
        for (int im = 0; im < 2; ++im) { const int u = mbase + im * 32; if (u >= NUNIT) continue;
#pragma unroll
            for (int in = 0; in < 2; ++in)
#pragma unroll
                for (int gq = 0; gq < 4; ++gq) { const int n = nb0 + in * 32 + 8 * gq + 4 * h; const f32x16& v = acc[in][im];
                    u32x2 o; o.x = pk2(v[4 * gq], v[4 * gq + 1]); o.y = pk2(v[4 * gq + 2], v[4 * gq + 3]); *(u32x2*)(ST + ((size_t)u * 32 + g) * 256 + n) = o; } }
    }
};
DI void stage_upproj(const Ctx& c) {
    constexpr int N_Q = 64 * 6, N_KV = 68 * 8, N_S1 = 32 * 5 * 2;
    LAS float* rs = (LAS float*)(c.lds + G_SCR);
    const bf16_t* P = c.ws<bf16_t>(WS_P);
    for (int it0 = c.bid; it0 < N_Q + N_KV + N_S1; it0 += c.G) {
        int it = it0;
        __syncthreads();
        if (it < N_Q) {
            const int mt = it / 6, nt = it % 6;
            { const int row = c.tid >> 1, hf = c.tid & 1; const bf16_t* pr = P + (size_t)(mt * 256 + row) * 1024 + hf * 128; float s = 0.f;
#pragma unroll
              for (int j = 0; j < 16; ++j) { const u32x4 v = *(const u32x4*)(pr + j * 8); const float a0 = lo16(v.x), a1 = hi16(v.x), a2 = lo16(v.y), a3 = hi16(v.y), a4 = lo16(v.z), a5 = hi16(v.z), a6 = lo16(v.w), a7 = hi16(v.w);
                  s += a0 * a0 + a1 * a1 + a2 * a2 + a3 * a3 + a4 * a4 + a5 * a5 + a6 * a6 + a7 * a7; }
              s += __shfl_xor(s, 1); if (hf == 0) rs[row] = rsqrtf(s * (1.f / 256.f) + EPS); }
            __syncthreads();
            RowLoader<4> al; al.base = P; al.ld = 1024; al.nrows = MLAT;
            RowLoader<2> wl; wl.base = c.ws<bf16_t>(WS_WTUQ); wl.ld = 256; wl.nrows = 768;
            EpiQ epi{c.ws<bf16_t>(WS_Q), rs, c.ws<float>(WS_ROPEC), c.ws<float>(WS_ROPES)};
            gemm_tile(c, al, wl, mt * 256, nt * 128, 256, epi, nullptr, -1);
            continue;
        }
        it -= N_Q;
        if (it < N_KV) {
            const int mt = it / 8, nt = it % 8;
            { const int row = c.tid >> 1, hf = c.tid & 1; const bf16_t* pr = P + (size_t)(mt * 256 + row) * 1024 + 256 + hf * 64; float s = 0.f;
#pragma unroll
              for (int j = 0; j < 8; ++j) { const u32x4 v = *(const u32x4*)(pr + j * 8); const float a0 = lo16(v.x), a1 = hi16(v.x), a2 = lo16(v.y), a3 = hi16(v.y), a4 = lo16(v.z), a5 = hi16(v.z), a6 = lo16(v.w), a7 = hi16(v.w);
                  s += a0 * a0 + a1 * a1 + a2 * a2 + a3 * a3 + a4 * a4 + a5 * a5 + a6 * a6 + a7 * a7; }
              s += __shfl_xor(s, 1); if (hf == 0) rs[row] = rsqrtf(s * (1.f / 128.f) + EPS); }
            if (nt == 0) {
                bf16_t* Kb = c.ws<bf16_t>(WS_K);
                for (int idx = c.tid; idx < 256 * 16; idx += NT) {
                    const int row = idx >> 4, i = idx & 15, m = mt * 256 + row;
                    const float t1 = bf2f(P[(size_t)m * 1024 + 384 + i]), t2 = bf2f(P[(size_t)m * 1024 + 400 + i]);
                    float o1 = t1, o2 = t2; int b, key;
                    if (m < MLAT) { b = m >> 12; key = m & 4095; const float cs = c.ws<float>(WS_ROPEC)[key * 16 + i], sn = c.ws<float>(WS_ROPES)[key * 16 + i]; o1 = t1 * cs - t2 * sn; o2 = t2 * cs + t1 * sn; }
                    else { b = (m - MLAT) >> 8; key = SEQ + ((m - MLAT) & 255); }
                    const bf16_t b1 = f2bf(o1), b2 = f2bf(o2);
#pragma unroll
                    for (int hd = 0; hd < NH; ++hd) { bf16_t* kp = Kb + ((size_t)(b * NH + hd) * NKEY + key) * 96; kp[64 + i] = b1; kp[80 + i] = b2; }
                }
            }
            __syncthreads();
            RowLoader<4> al; al.base = P + 256; al.ld = 1024; al.nrows = MALL;
            RowLoader<2> wl; wl.base = c.ws<bf16_t>(WS_WTUKV); wl.ld = 128; wl.nrows = 1024;
            EpiKV epi{c.ws<bf16_t>(WS_K), c.ws<bf16_t>(WS_VT), rs};
            gemm_tile(c, al, wl, mt * 256, nt * 128, 128, epi, nullptr, -1);
            continue;
        }
        it -= N_KV;
        {
            const int g = it / 10, mt = (it % 10) >> 1, nt = it & 1;
            UcLoader al; al.P = P; al.g = g;
            RowLoader<2> wl; wl.base = c.ws<bf16_t>(WS_M16) + (size_t)g * 256 * 256; wl.ld = 256; wl.nrows = 256;
            EpiST epi{c.ws<bf16_t>(WS_ST), g};
            gemm_tile(c, al, wl, mt * 256, nt * 128, 256, epi, nullptr, -1);
        }
    }
}

DI void stage_carry(const Ctx& c) {
    const int gt = c.bid * NT + c.tid;
    if (gt >= NB * 32 * 2 * 64) return;
    const int p = gt & 63, d = (gt >> 6) & 1, g = (gt >> 7) & 31, b = gt >> 12;
    const float2 a16 = c.ws<float2>(WS_PW)[(size_t)((d * 32 + g) * 64 + p) * 20 + 16];
    bf16_t* st = c.ws<bf16_t>(WS_ST) + ((size_t)(b * NUNIT_B) * 32 + g) * 256 + d * 128 + p;
    float er = 0.f, ei = 0.f;
    for (int s0 = 0; s0 < NUNIT_B; s0 += 16) {
        float vr[16], vi[16];
#pragma unroll
        for (int q = 0; q < 16; ++q) { const int s = s0 + q; const int ci = d == 0 ? s : (s < 16 ? 15 - s : (NUNIT_B - 1) - (s - 16)); vr[q] = bf2f(st[(size_t)ci * 8192]); vi[q] = bf2f(st[(size_t)ci * 8192 + 64]); }
#pragma unroll
        for (int q = 0; q < 16; ++q) { const int s = s0 + q; const int ci = d == 0 ? s : (s < 16 ? 15 - s : (NUNIT_B - 1) - (s - 16));
            st[(size_t)ci * 8192] = f2bf(er); st[(size_t)ci * 8192 + 64] = f2bf(ei);
            const float nr = a16.x * er - a16.y * ei + vr[q], ni = a16.x * ei + a16.y * er + vi[q]; er = nr; ei = ni; }
    }
}

struct SsmALoader {
    const bf16_t* P; const bf16_t* ST; int g; const bf16_t* sp[4]; const bf16_t* up[4];
    DI void init(int i, int u) { const int uu = u < NUNIT ? u : NUNIT - 1; sp[i] = ST + ((size_t)uu * 32 + g) * 256; up[i] = P + (size_t)unit_row0(uu) * 1024 + 512 + 16 * g; }
    DI u32x4 load(int i, int k) const { if (k < 256) return *(const u32x4*)(sp[i] + k); const int kk = k - 256; return *(const u32x4*)(up[i] + (kk >> 4) * 1024 + (kk & 15)); }
};
struct EpiG {
    bf16_t* Gb; int g;
    DI void run(const f32x16 (&acc)[2][2], int mbase, int nb0, int h, int) const {
#pragma unroll
        for (int im = 0; im < 2; ++im) { const int u = mbase + im * 32; if (u >= NUNIT) continue; const int b = u / NUNIT_B, cc = u % NUNIT_B; if (cc < 16) continue;
            const int row0 = b * SEQ + 16 * (cc - 16);
#pragma unroll
            for (int in = 0; in < 2; ++in)
#pragma unroll
                for (int gq = 0; gq < 4; ++gq) { const int n = nb0 + in * 32 + 8 * gq + 4 * h, i = n >> 4, hh = n & 15; const f32x16& v = acc[in][im];
                    u32x2 o; o.x = pk2(geluf_(v[4 * gq]), geluf_(v[4 * gq + 1])); o.y = pk2(geluf_(v[4 * gq + 2]), geluf_(v[4 * gq + 3]));
                    *(u32x2*)(Gb + (size_t)(row0 + i) * 512 + 16 * g + hh) = o; } }
    }
};
DI void stage_ssmout(const Ctx& c) {
    for (int it = c.bid; it < 320; it += c.G) {
        const int g = it / 10, mt = (it % 10) >> 1, nt = it & 1;
        SsmALoader al; al.P = c.ws<bf16_t>(WS_P); al.ST = c.ws<bf16_t>(WS_ST); al.g = g;
        RowLoader<2> wl; wl.base = c.ws<bf16_t>(WS_W3) + (size_t)g * 256 * 512; wl.ld = 512; wl.nrows = 256;
        EpiG epi{c.ws<bf16_t>(WS_G), g};
        gemm_tile(c, al, wl, mt * 256, nt * 128, 512, epi, nullptr, -1);
    }
}

struct EpiGLU {
    const bf16_t* Gb; bf16_t* Mix; const float* bias;
    DI void run(const f32x16 (&acc)[2][2], int mbase, int nb0, int h, int) const {
#pragma unroll
        for (int im = 0; im < 2; ++im) { const int m = mbase + im * 32;
#pragma unroll
            for (int in = 0; in < 2; ++in)
#pragma unroll
                for (int g = 0; g < 4; ++g) { const int n = nb0 + in * 32 + 8 * g + 4 * h; const f32x16& v = acc[in][im];
                    const u32x2 gg = *(const u32x2*)(Gb + (size_t)m * 512 + n); const f32x4 bb = *(const f32x4*)(bias + n);
                    const float g0 = lo16(gg.x), g1 = hi16(gg.x), g2 = lo16(gg.y), g3 = hi16(gg.y);
                    u32x2 o; o.x = pk2(g0 * sigmoidf_(v[4 * g] + bb.x), g1 * sigmoidf_(v[4 * g + 1] + bb.y)); o.y = pk2(g2 * sigmoidf_(v[4 * g + 2] + bb.z), g3 * sigmoidf_(v[4 * g + 3] + bb.w));
                    *(u32x2*)(Mix + (size_t)m * 1024 + 512 + n) = o; } }
    }
};
DI void stage_glu(const Ctx& c) {
    for (int it = c.bid; it < 64 * 4; it += c.G) {
        const int mt = it >> 2, nt = it & 3;
        RowLoader<4> al; al.base = c.ws<bf16_t>(WS_G); al.ld = 512; al.nrows = MLAT;
        RowLoader<2> wl; wl.base = c.ws<bf16_t>(WS_WTGLU); wl.ld = 512; wl.nrows = 512;
        EpiGLU epi{c.ws<bf16_t>(WS_G), c.ws<bf16_t>(WS_MIX), c.in(I_BGLU)};
        gemm_tile(c, al, wl, mt * 256, nt * 128, 512, epi, nullptr, -1);
    }
    constexpr int PER_GU = 16 * 4, PER_D = 4 * 16;
    for (int it = c.bid; it < 32 * (2 * PER_GU + PER_D); it += c.G) {
        const int e = it / (2 * PER_GU + PER_D); int r = it % (2 * PER_GU + PER_D);
        if (r < PER_GU) { const int kb = r >> 2, jb = r & 3; tr_tile(c, c.in(I_WEG) + (size_t)e * 1024 * 256, 256, kb * 64, jb * 64, c.ws<bf16_t>(WS_WGU) + (size_t)e * 512 * 1024, 1024, 2, nullptr); continue; }
        r -= PER_GU;
        if (r < PER_GU) { const int kb = r >> 2, jb = r & 3; tr_tile(c, c.in(I_WEU) + (size_t)e * 1024 * 256, 256, kb * 64, jb * 64, c.ws<bf16_t>(WS_WGU) + (size_t)e * 512 * 1024, 1024, 3, nullptr); continue; }
        r -= PER_GU;
        { const int kb = r >> 4, jb = r & 15; tr_tile(c, c.in(I_WED) + (size_t)e * 256 * 1024, 1024, kb * 64, jb * 64, c.ws<bf16_t>(WS_WD) + (size_t)e * 1024 * 256, 256, 0, nullptr); }
    }
}

constexpr int AT_KROW = 208, AT_VROW = 144, AT_KBYTES = 64 * AT_KROW, AT_STAGE = AT_KBYTES + 64 * AT_VROW;
DI void stage_attn(const Ctx& c) {
    const int lane = c.lane, wid = c.wid, r = lane & 31, h = lane >> 5, tid = c.tid;
    const bf16_t* Qb = c.ws<bf16_t>(WS_Q); const bf16_t* Kb = c.ws<bf16_t>(WS_K); const bf16_t* Vt = c.ws<bf16_t>(WS_VT);
    bf16_t* Mix = c.ws<bf16_t>(WS_MIX);
    for (int unit = c.bid; unit < NB * NH * 16; unit += c.G) {
        const int qb = unit & 15, bh = unit >> 4, b = bh >> 3, hd = bh & 7;
        const int q0 = qb * 256 + wid * 32;
        bf16x8 qf[6];
        { const bf16_t* qp = Qb + ((size_t)bh * SEQ + q0 + r) * 96 + 8 * h;
#pragma unroll
          for (int ks = 0; ks < 6; ++ks) qf[ks] = *(const bf16x8*)(qp + ks * 16); }
        const bf16_t* kbase = Kb + (size_t)bh * NKEY * 96;
        const bf16_t* vbase = Vt + (size_t)bh * 64 * NKEY;
        const int kq0 = tid, kq1 = tid + 512;
        const int vd = tid >> 3, vc = tid & 7;
        u32x4 rk0, rk1 = (u32x4){0u, 0u, 0u, 0u}, rv;
        f32x16 o[2]; float mrun = -1e30f, lrun = 0.f;
#pragma unroll
        for (int i = 0; i < 2; ++i)
#pragma unroll
            for (int e = 0; e < 16; ++e) o[i][e] = 0.f;
        __syncthreads();
        rk0 = *(const u32x4*)(kbase + (size_t)kq0 * 8); if (tid < 256) rk1 = *(const u32x4*)(kbase + (size_t)kq1 * 8);
        rv = *(const u32x4*)(vbase + (size_t)vd * NKEY + vc * 8);
        { LAS unsigned char* sb = c.lds;
          *(LAS u32x4*)(sb + (kq0 / 12) * AT_KROW + (kq0 % 12) * 16) = rk0; if (tid < 256) *(LAS u32x4*)(sb + (kq1 / 12) * AT_KROW + (kq1 % 12) * 16) = rk1;
          *(LAS u32x4*)(sb + AT_KBYTES + vd * AT_VROW + vc * 16) = rv; }
        __syncthreads();
        constexpr int NTILE = NKEY / 64;
        for (int t = 0; t < NTILE; ++t) {
            const int buf = t & 1;
            if (t + 1 < NTILE) {
                const bf16_t* kt = kbase + (size_t)(t + 1) * 64 * 96;
                rk0 = *(const u32x4*)(kt + (size_t)kq0 * 8); if (tid < 256) rk1 = *(const u32x4*)(kt + (size_t)kq1 * 8);
                rv = *(const u32x4*)(vbase + (size_t)vd * NKEY + (t + 1) * 64 + vc * 8);
            }
            const LAS unsigned char* sk = c.lds + buf * AT_STAGE + r * AT_KROW + h * 16;
            const LAS unsigned char* sv = c.lds + buf * AT_STAGE + AT_KBYTES + r * AT_VROW + h * 16;
            f32x16 st[2];
#pragma unroll
            for (int kt2 = 0; kt2 < 2; ++kt2) {
#pragma unroll
                for (int e = 0; e < 16; ++e) st[kt2][e] = 0.f;
#pragma unroll
                for (int ks = 0; ks < 6; ++ks) { const bf16x8 kf = *(const LAS bf16x8*)(sk + kt2 * 32 * AT_KROW + ks * 32); st[kt2] = MFMA32(kf, qf[ks], st[kt2]); }
            }
            float mx = st[0][0];
#pragma unroll
            for (int e = 1; e < 16; ++e) mx = fmaxf(mx, st[0][e]);
#pragma unroll
            for (int e = 0; e < 16; ++e) mx = fmaxf(mx, st[1][e]);
            mx = fmaxf(mx, __shfl_xor(mx, 32));
            const float mnew = fmaxf(mrun, mx), alpha = __builtin_amdgcn_exp2f(mrun - mnew);
            mrun = mnew;
            float ps = 0.f;
#pragma unroll
            for (int kt2 = 0; kt2 < 2; ++kt2)
#pragma unroll
                for (int e = 0; e < 16; ++e) { const float pv = __builtin_amdgcn_exp2f(st[kt2][e] - mnew); st[kt2][e] = pv; ps += pv; }
            lrun = lrun * alpha + ps;
#pragma unroll
            for (int i = 0; i < 2; ++i)
#pragma unroll
                for (int e = 0; e < 16; ++e) o[i][e] *= alpha;
#pragma unroll
            for (int kt2 = 0; kt2 < 2; ++kt2)
#pragma unroll
                for (int s = 0; s < 2; ++s) {
                    u32x4 pp; pp.x = pk2(st[kt2][8 * s], st[kt2][8 * s + 1]); pp.y = pk2(st[kt2][8 * s + 2], st[kt2][8 * s + 3]); pp.z = pk2(st[kt2][8 * s + 4], st[kt2][8 * s + 5]); pp.w = pk2(st[kt2][8 * s + 6], st[kt2][8 * s + 7]);
                    const bf16x8 pb = __builtin_bit_cast(bf16x8, pp);
#pragma unroll
                    for (int dt = 0; dt < 2; ++dt) { const bf16x8 vf = *(const LAS bf16x8*)(sv + dt * 32 * AT_VROW + (kt2 * 32 + s * 16) * 2); o[dt] = MFMA32(vf, pb, o[dt]); }
                }
            if (t + 1 < NTILE) {
                LAS unsigned char* sb = c.lds + (buf ^ 1) * AT_STAGE;
                *(LAS u32x4*)(sb + (kq0 / 12) * AT_KROW + (kq0 % 12) * 16) = rk0; if (tid < 256) *(LAS u32x4*)(sb + (kq1 / 12) * AT_KROW + (kq1 % 12) * 16) = rk1;
                *(LAS u32x4*)(sb + AT_KBYTES + vd * AT_VROW + vc * 16) = rv;
            }
            __syncthreads();
        }
        const float linv = 1.f / (lrun + __shfl_xor(lrun, 32));
        bf16_t* op = Mix + (size_t)(b * SEQ + q0 + r) * 1024 + hd * 64;
#pragma unroll
        for (int dt = 0; dt < 2; ++dt)
#pragma unroll
            for (int g = 0; g < 4; ++g) { u32x2 w; w.x = pk2(o[dt][4 * g] * linv, o[dt][4 * g + 1] * linv); w.y = pk2(o[dt][4 * g + 2] * linv, o[dt][4 * g + 3] * linv);
                *(u32x2*)(op + dt * 32 + 8 * g + 4 * h) = w; }
    }
}

struct EpiWo {
    const float* x; float* out; const float* mod; const LAS float* rssm;
    DI void run(const f32x16 (&acc)[2][2], int mbase, int nb0, int h, int lrow) const {
#pragma unroll
        for (int im = 0; im < 2; ++im) { const int m = mbase + im * 32, b = m >> 12; const float rs = rssm[lrow + im * 32]; const float* ga = mod + (size_t)b * 6144 + 2048;
#pragma unroll
            for (int in = 0; in < 2; ++in)
#pragma unroll
                for (int g = 0; g < 4; ++g) { const int n = nb0 + in * 32 + 8 * g + 4 * h; const f32x16& v = acc[in][im];
                    const f32x4 xv = *(const f32x4*)(x + (size_t)m * 1024 + n), gv = *(const f32x4*)(ga + n);
                    f32x4 o; o.x = ALPHA * xv.x + gv.x * (v[4 * g] * rs); o.y = ALPHA * xv.y + gv.y * (v[4 * g + 1] * rs); o.z = ALPHA * xv.z + gv.z * (v[4 * g + 2] * rs); o.w = ALPHA * xv.w + gv.w * (v[4 * g + 3] * rs);
                    *(f32x4*)(out + (size_t)m * 1024 + n) = o; } }
    }
};
DI void stage_wo(const Ctx& c) {
    LAS float* ratio = (LAS float*)(c.lds + G_SCR);
    LAS float* rssm = ratio + 256;
    const bf16_t* Mix = c.ws<bf16_t>(WS_MIX);
    for (int it = c.bid; it < 64 * 8; it += c.G) {
        const int mt = it >> 3, nt = it & 7;
        __syncthreads();
        { const int row = c.tid >> 1, hf = c.tid & 1; const bf16_t* pr = Mix + (size_t)(mt * 256 + row) * 1024 + hf * 512; float s = 0.f;
          for (int j = 0; j < 64; ++j) { const u32x4 v = *(const u32x4*)(pr + j * 8); const float a0 = lo16(v.x), a1 = hi16(v.x), a2 = lo16(v.y), a3 = hi16(v.y), a4 = lo16(v.z), a5 = hi16(v.z), a6 = lo16(v.w), a7 = hi16(v.w);
              s += a0 * a0 + a1 * a1 + a2 * a2 + a3 * a3 + a4 * a4 + a5 * a5 + a6 * a6 + a7 * a7; }
          const float rme = rsqrtf(s * (1.f / 512.f) + EPS), rot = __shfl_xor(rme, 1);
          if (hf == 0) { ratio[row] = rme / rot; rssm[row] = rot; } }
        __syncthreads();
        RowLoader<4> al; al.base = Mix; al.ld = 1024; al.nrows = MLAT;
        RowLoader<2> wl; wl.base = c.ws<bf16_t>(WS_WTO); wl.ld = 1024; wl.nrows = 1024;
        EpiWo epi{c.in(I_X), c.p.out, c.ws<float>(WS_MOD), rssm};
        gemm_tile(c, al, wl, mt * 256, nt * 128, 1024, epi, ratio, 7);
    }
}

DI void stage_ln1(const Ctx& c) {
    const float* mod = c.ws<float>(WS_MOD); const float* wr = c.ws<float>(WS_WRT);
    unsigned* ctl = c.ws<unsigned>(WS_CTL);
    for (int row = c.bid * 8 + c.wid; row < MLAT; row += c.G * 8) {
        const int b = row >> 12; float* orow = c.p.out + (size_t)row * 1024;
        f32x4 y[4]; float s = 0.f;
#pragma unroll
        for (int j = 0; j < 4; ++j) { y[j] = *(const f32x4*)(orow + (c.lane + 64 * j) * 4); s += (y[j].x + y[j].y) + (y[j].z + y[j].w); }
        const float mean = wave_sum(s) * (1.f / 1024.f); float q = 0.f;
#pragma unroll
        for (int j = 0; j < 4; ++j) { y[j] = y[j] - mean; q += (y[j].x * y[j].x + y[j].y * y[j].y) + (y[j].z * y[j].z + y[j].w * y[j].w); }
        const float rstd = rsqrtf(wave_sum(q) * (1.f / 1024.f) + EPS);
        f32x4 hv[4];
#pragma unroll
        for (int j = 0; j < 4; ++j) { const int n = (c.lane + 64 * j) * 4;
            const f32x4 g = *(const f32x4*)(c.in(I_LN1G) + n), bb = *(const f32x4*)(c.in(I_LN1B) + n);
            const f32x4 x1 = y[j] * rstd * g + bb; *(f32x4*)(orow + n) = x1;
            const f32x4 sh = *(const f32x4*)(mod + (size_t)b * 6144 + 3072 + n), sc = *(const f32x4*)(mod + (size_t)b * 6144 + 4096 + n);
            hv[j] = x1 * (1.f + sc) + sh;
            u32x2 o; o.x = pk2(hv[j].x, hv[j].y); o.y = pk2(hv[j].z, hv[j].w); *(u32x2*)(c.ws<bf16_t>(WS_H) + (size_t)row * 1024 + n) = o; }
        LAS float* lg = (LAS float*)(c.lds) + c.wid * 40;
#pragma unroll 2
        for (int e = 0; e < 36; ++e) { float a = 0.f;
#pragma unroll
            for (int j = 0; j < 4; ++j) { const f32x4 w = *(const f32x4*)(wr + e * 1024 + (c.lane + 64 * j) * 4); a += (hv[j].x * w.x + hv[j].y * w.y) + (hv[j].z * w.z + hv[j].w * w.w); }
            a = wave_sum(a) + (e < 4 ? c.in(I_BRG)[e] : c.in(I_BRE2)[e - 4]);
            if (c.lane == 0) lg[e] = a; }
        asm volatile("s_waitcnt lgkmcnt(0)" ::: "memory");
        int gi = 0; float gm = lg[0];
#pragma unroll
        for (int e = 1; e < 4; ++e) if (lg[e] > gm) { gm = lg[e]; gi = e; }
        float gs = 0.f;
#pragma unroll
        for (int e = 0; e < 4; ++e) gs += __expf(lg[e] - gm);
        const float gw = 1.f / gs;
        float el[8];
#pragma unroll
        for (int j = 0; j < 8; ++j) el[j] = lg[4 + gi * 8 + j];
        int i1 = 0; float l1 = el[0];
#pragma unroll
        for (int j = 1; j < 8; ++j) if (el[j] > l1) { l1 = el[j]; i1 = j; }
        int i2 = -1; float l2 = -3.0e38f;
#pragma unroll
        for (int j = 0; j < 8; ++j) if (j != i1 && el[j] > l2) { l2 = el[j]; i2 = j; }
        const float ex = __expf(l2 - l1), w1 = gw / (1.f + ex), w2 = gw * ex / (1.f + ex);
        if (c.lane == 0) {
            const int e1 = gi * 8 + i1, e2 = gi * 8 + i2;
            const unsigned p1 = atomicAdd(&ctl[CW_CNT + e1], 1u), p2 = atomicAdd(&ctl[CW_CNT + e2], 1u);
            int* list = c.ws<int>(WS_LIST); float* tw = c.ws<float>(WS_TOKW);
            list[e1 * 16384 + p1] = row * 2; list[e2 * 16384 + p2] = row * 2 + 1; tw[row * 2] = w1; tw[row * 2 + 1] = w2;
        }
    }
}

struct GatherLoader {
    const bf16_t* src; const int* list; int cnt, ld, shift; const bf16_t* rp[4];
    DI void init(int i, int m) { const int ts = list[m < cnt ? m : cnt - 1]; rp[i] = src + (size_t)(ts >> shift) * ld; }
    DI u32x4 load(int i, int k) const { return *(const u32x4*)(rp[i] + k); }
};
struct EpiZ {
    bf16_t* Z; const int* list; const float* tw; int cnt, m00;
    DI void run(const f32x16 (&acc)[2][2], int mbase, int nb0, int h, int) const {
#pragma unroll
        for (int im = 0; im < 2; ++im) { const int ml = mbase + im * 32 - m00; if (ml >= cnt) continue; const int ts = list[ml]; const float w = tw[ts];
            const int jb = (nb0 >> 6) * 32;
#pragma unroll
            for (int g = 0; g < 4; ++g) { const f32x16& a = acc[0][im]; const f32x16& u = acc[1][im];
                u32x2 o; o.x = pk2(siluf_(a[4 * g]) * u[4 * g] * w, siluf_(a[4 * g + 1]) * u[4 * g + 1] * w); o.y = pk2(siluf_(a[4 * g + 2]) * u[4 * g + 2] * w, siluf_(a[4 * g + 3]) * u[4 * g + 3] * w);
                *(u32x2*)(Z + (size_t)ts * 256 + jb + 8 * g + 4 * h) = o; } }
    }
};
struct EpiF {
    bf16_t* F; const int* list; int cnt, m00;
    DI void run(const f32x16 (&acc)[2][2], int mbase, int nb0, int h, int) const {
#pragma unroll
        for (int im = 0; im < 2; ++im) { const int ml = mbase + im * 32 - m00; if (ml >= cnt) continue; const int ts = list[ml];
#pragma unroll
            for (int in = 0; in < 2; ++in)
#pragma unroll
                for (int g = 0; g < 4; ++g) { const int n = nb0 + in * 32 + 8 * g + 4 * h; const f32x16& v = acc[in][im];
                    u32x2 o; o.x = pk2(v[4 * g], v[4 * g + 1]); o.y = pk2(v[4 * g + 2], v[4 * g + 3]); *(u32x2*)(F + (size_t)ts * 1024 + n) = o; } }
    }
};
template <int DOWN> DI void stage_expert(const Ctx& c) {
    unsigned* ctl = c.ws<unsigned>(WS_CTL);
    constexpr int NNT = DOWN ? 8 : 4;
    int tot = 0;
    for (int e = 0; e < 32; ++e) tot += (int)((xb_ld(&ctl[CW_CNT + e]) + 255u) >> 8) * NNT;
    for (int it = c.bid; it < tot; it += c.G) {
        int e = 0, acc0 = 0, cnt = 0;
        for (; e < 32; ++e) { cnt = (int)xb_ld(&ctl[CW_CNT + e]); const int ni = ((cnt + 255) >> 8) * NNT; if (it < acc0 + ni) break; acc0 += ni; }
        const int r = it - acc0, mt = r / NNT, nt = r % NNT;
        const int* list = c.ws<int>(WS_LIST) + e * 16384;
        if (!DOWN) {
            GatherLoader al; al.src = c.ws<bf16_t>(WS_H); al.list = list; al.cnt = cnt; al.ld = 1024; al.shift = 1;
            RowLoader<2> wl; wl.base = c.ws<bf16_t>(WS_WGU) + (size_t)e * 512 * 1024; wl.ld = 1024; wl.nrows = 512;
            EpiZ epi{c.ws<bf16_t>(WS_Z), list, c.ws<float>(WS_TOKW), cnt, 0};
            gemm_tile(c, al, wl, mt * 256, nt * 128, 1024, epi, nullptr, -1);
        } else {
            GatherLoader al; al.src = c.ws<bf16_t>(WS_Z); al.list = list; al.cnt = cnt; al.ld = 256; al.shift = 0;
            RowLoader<2> wl; wl.base = c.ws<bf16_t>(WS_WD) + (size_t)e * 1024 * 256; wl.ld = 256; wl.nrows = 1024;
            EpiF epi{c.ws<bf16_t>(WS_F), list, cnt, 0};
            gemm_tile(c, al, wl, mt * 256, nt * 128, 256, epi, nullptr, -1);
        }
    }
}

DI void stage_final(const Ctx& c) {
    const float* mod = c.ws<float>(WS_MOD); const bf16_t* F = c.ws<bf16_t>(WS_F);
    for (int row = c.bid * 8 + c.wid; row < MLAT; row += c.G * 8) {
        const int b = row >> 12; float* orow = c.p.out + (size_t)row * 1024;
        f32x4 y[4]; float s = 0.f;
#pragma unroll
        for (int j = 0; j < 4; ++j) { const int n = (c.lane + 64 * j) * 4;
            const f32x4 x1 = *(const f32x4*)(orow + n), gf = *(const f32x4*)(mod + (size_t)b * 6144 + 5120 + n);
            const u32x2 f0 = *(const u32x2*)(F + (size_t)(row * 2) * 1024 + n), f1 = *(const u32x2*)(F + (size_t)(row * 2 + 1) * 1024 + n);
            f32x4 ff; ff.x = lo16(f0.x) + lo16(f1.x); ff.y = hi16(f0.x) + hi16(f1.x); ff.z = lo16(f0.y) + lo16(f1.y); ff.w = hi16(f0.y) + hi16(f1.y);
            y[j] = ALPHA * x1 + gf * ff; s += (y[j].x + y[j].y) + (y[j].z + y[j].w); }
        const float mean = wave_sum(s) * (1.f / 1024.f); float q = 0.f;
#pragma unroll
        for (int j = 0; j < 4; ++j) { y[j] = y[j] - mean; q += (y[j].x * y[j].x + y[j].y * y[j].y) + (y[j].z * y[j].z + y[j].w * y[j].w); }
        const float rstd = rsqrtf(wave_sum(q) * (1.f / 1024.f) + EPS);
#pragma unroll
        for (int j = 0; j < 4; ++j) { const int n = (c.lane + 64 * j) * 4;
            const f32x4 g = *(const f32x4*)(c.in(I_LN2G) + n), bb = *(const f32x4*)(c.in(I_LN2B) + n);
            *(f32x4*)(orow + n) = y[j] * rstd * g + bb; }
    }
}

#if DEBUG_CHECK
DI void chk_fail(const Ctx& c, int stage) { atomicMax(c.ws<unsigned>(WS_CTL) + CW_CHK, (unsigned)(64 - stage)); }
DI bool chk_cmp(float got, float ref, float scale) { const float d = fabsf(got - ref); return !(d <= 0.03f * fabsf(ref) + 0.03f * scale); }
DI unsigned hash_u(unsigned x) { x ^= x >> 16; x *= 0x7feb352du; x ^= x >> 15; x *= 0x846ca68bu; x ^= x >> 16; return x; }
DI void chk_stage12(const Ctx& c) {
    const int gt = c.bid * NT + c.tid, GT = c.G * NT;
    const float* mod = c.ws<float>(WS_MOD);
    for (int i = gt; i < 5 * 6144; i += GT * 4) {
        const int r = i / 6144, j = i % 6144; float s = c.in(I_BADA)[j];
        for (int k = 0; k < 1024; ++k) { const float v = r < 4 ? c.in(I_C)[r * 1024 + k] : c.in(I_CCTX)[k]; s += siluf_(v) * c.in(I_WADA)[(size_t)k * 6144 + j]; }
        if (chk_cmp(mod[i], s, 0.1f)) chk_fail(c, 1);
    }
    for (int sidx = gt; sidx < 8192; sidx += GT) {
        const unsigned hsh = hash_u(sidx * 2654435761u + 12345u);
        const int row = hsh % MALL, n = (hsh >> 16) % 1024;
        const int src = n < 416 ? n : (n < 512 ? -1 : n - 96);
        const int mr = row < MLAT ? row / SEQ : 4;
        const float* xr = row < MLAT ? c.in(I_X) + (size_t)row * 1024 : c.in(I_CTX) + (size_t)(row - MLAT) * 1024;
        float s = 0.f;
        if (src >= 0) for (int k = 0; k < 1024; ++k) s += (xr[k] * (1.f + mod[mr * 6144 + 1024 + k]) + mod[mr * 6144 + k]) * c.in(I_WIN)[(size_t)k * 928 + src];
        if (chk_cmp(bf2f(c.ws<bf16_t>(WS_P)[(size_t)row * 1024 + n]), s, 1.0f)) chk_fail(c, 2);
    }
}
DI void chk_stage3(const Ctx& c) {
    const int gt = c.bid * NT + c.tid, GT = c.G * NT;
    const bf16_t* P = c.ws<bf16_t>(WS_P);
    for (int sidx = gt; sidx < 4096; sidx += GT) {
        const unsigned hsh = hash_u(sidx * 2654435761u + 777u);
        {
            const int row = hsh % MLAT, head = (hsh >> 16) & 7, d = (hsh >> 20) % 96, b = row >> 12, t = row & 4095;
            float ss = 0.f; for (int k = 0; k < 256; ++k) { const float v = bf2f(P[(size_t)row * 1024 + k]); ss += v * v; }
            const float rq = rsqrtf(ss / 256.f + EPS);
            auto qcol = [&](int n) { float s = 0.f; for (int k = 0; k < 256; ++k) s += bf2f(P[(size_t)row * 1024 + k]) * rq * c.in(I_QNG)[k] * c.in(I_WUQ)[(size_t)k * 768 + n]; return s; };
            float ref;
            if (d < 64) ref = qcol(head * 96 + d);
            else { const int i = d - 64, ii = i & 15; const float t1 = qcol(head * 96 + 64 + ii), t2 = qcol(head * 96 + 80 + ii);
                const int pos = (ii < 8) ? (t >> 6) : (t & 63); const float ang = (float)pos * powf(10000.f, -(float)(ii & 7) / 8.f); const float cs = cosf(ang), sn = sinf(ang);
                ref = i < 16 ? t1 * cs - t2 * sn : t2 * cs + t1 * sn; }
            ref *= QSCALE;
            if (chk_cmp(bf2f(c.ws<bf16_t>(WS_Q)[((size_t)(b * NH + head) * SEQ + t) * 96 + d]), ref, 0.2f)) chk_fail(c, 3);
        }
        {
            const unsigned h2 = hash_u(hsh + 99u);
            const int row = h2 % MALL, head = (h2 >> 16) & 7, dd = (h2 >> 20) % 160;
            int b, key; if (row < MLAT) { b = row >> 12; key = row & 4095; } else { b = (row - MLAT) >> 8; key = SEQ + ((row - MLAT) & 255); }
            float ss = 0.f; for (int k = 0; k < 128; ++k) { const float v = bf2f(P[(size_t)row * 1024 + 256 + k]); ss += v * v; }
            const float rk = rsqrtf(ss / 128.f + EPS);
            auto kvcol = [&](int n) { float s = 0.f; for (int k = 0; k < 128; ++k) s += bf2f(P[(size_t)row * 1024 + 256 + k]) * rk * c.in(I_KVNG)[k] * c.in(I_WUKV)[(size_t)k * 1024 + n]; return s; };
            float ref, got;
            if (dd < 64) { ref = kvcol(head * 128 + dd); got = bf2f(c.ws<bf16_t>(WS_K)[((size_t)(b * NH + head) * NKEY + key) * 96 + dd]); }
            else if (dd < 96) { const int i = dd - 64, ii = i & 15; const float t1 = bf2f(P[(size_t)row * 1024 + 384 + ii]), t2 = bf2f(P[(size_t)row * 1024 + 400 + ii]);
                if (row < MLAT) { const int pos = (ii < 8) ? (key >> 6) : (key & 63); const float ang = (float)pos * powf(10000.f, -(float)(ii & 7) / 8.f); const float cs = cosf(ang), sn = sinf(ang); ref = i < 16 ? t1 * cs - t2 * sn : t2 * cs + t1 * sn; }
                else ref = i < 16 ? t1 : t2;
                got = bf2f(c.ws<bf16_t>(WS_K)[((size_t)(b * NH + head) * NKEY + key) * 96 + dd]); }
            else { const int d = dd - 96; ref = kvcol(head * 128 + 64 + d); got = bf2f(c.ws<bf16_t>(WS_VT)[((size_t)(b * NH + head) * 64 + d) * NKEY + keypos(key)]); }
            if (chk_cmp(got, ref, 0.5f)) chk_fail(c, 3);
        }
    }
}
DI void chk_stage4(const Ctx& c) {
    const bf16_t* P = c.ws<bf16_t>(WS_P);
    const int p = c.lane;
    for (int sidx = c.bid * 8 + c.wid; sidx < 2048; sidx += c.G * 8) {
        const unsigned hsh = hash_u(sidx * 2654435761u + 4242u);
        const int b = hsh & 3, g = (hsh >> 2) & 31; int t = (hsh >> 8) & 4095;
        if ((sidx & 3) == 0) t = (sidx & 4) ? 4095 - (t & 31) : (t & 31);
        float y[16];
#pragma unroll
        for (int i = 0; i < 16; ++i) y[i] = 0.f;
        for (int d = 0; d < 2; ++d) {
            const int dg = d * 32 + g, idx = dg * 64 + p;
            const double are = c.in(I_ARE)[idx], aim = c.in(I_AIM)[idx], dt = exp((double)c.in(I_LOGDT)[dg]);
            const double mag = exp(are * dt), abr = mag * cos(aim * dt), abi = mag * sin(aim * dt), den = are * are + aim * aim, nre = abr - 1.0;
            const float cre = (float)((nre * are + abi * aim) / den), cim = (float)((abi * are - nre * aim) / den);
            const float ar = (float)abr, ai = (float)abi;
            float bbr[16], bbi[16];
#pragma unroll
            for (int hh = 0; hh < 16; ++hh) { const float br = c.in(I_BRE)[(size_t)idx * 16 + hh], bi = c.in(I_BIM)[(size_t)idx * 16 + hh]; bbr[hh] = cre * br - cim * bi; bbi[hh] = cre * bi + cim * br; }
            float sr = 0.f, si = 0.f;
            const int nlat = d == 0 ? t + 1 : SEQ - t;
            for (int s = 0; s < CTXL + nlat; ++s) {
                int row; if (s < CTXL) row = MLAT + b * CTXL + (d == 0 ? s : CTXL - 1 - s); else row = b * SEQ + (d == 0 ? s - CTXL : SEQ - 1 - (s - CTXL));
                const bf16_t* up = P + (size_t)row * 1024 + 512 + 16 * g;
                float bur = 0.f, bui = 0.f;
#pragma unroll
                for (int hh = 0; hh < 16; ++hh) { const float u = bf2f(up[hh]); bur += bbr[hh] * u; bui += bbi[hh] * u; }
                const float nr = ar * sr - ai * si + bur, ni = ar * si + ai * sr + bui; sr = nr; si = ni;
            }
#pragma unroll
            for (int hh = 0; hh < 16; ++hh) { const float v = c.in(I_CRE)[(size_t)(dg * 16 + hh) * 64 + p] * sr - c.in(I_CIM)[(size_t)(dg * 16 + hh) * 64 + p] * si; y[hh] += wave_sum(v); }
        }
        if (c.lane < 16) {
            const int row = b * SEQ + t; float yy = 0.f;
#pragma unroll
            for (int hh = 0; hh < 16; ++hh) if (hh == c.lane) yy = y[hh];
            const float u = bf2f(P[(size_t)row * 1024 + 512 + 16 * g + c.lane]);
            const float ref = geluf_(yy + c.in(I_SSMD)[16 * g + c.lane] * u);
            if (chk_cmp(bf2f(c.ws<bf16_t>(WS_G)[(size_t)row * 512 + 16 * g + c.lane]), ref, 0.3f)) chk_fail(c, 4);
        }
    }
}
DI void chk_stage56(const Ctx& c) {
    const int gt = c.bid * NT + c.tid, GT = c.G * NT;
    const bf16_t* Gb = c.ws<bf16_t>(WS_G); const bf16_t* Mix = c.ws<bf16_t>(WS_MIX);
    for (int sidx = gt; sidx < 8192; sidx += GT) {
        const unsigned hsh = hash_u(sidx * 2654435761u + 555u); const int row = hsh % MLAT, n = (hsh >> 16) & 511;
        float s = c.in(I_BGLU)[n]; for (int k = 0; k < 512; ++k) s += bf2f(Gb[(size_t)row * 512 + k]) * c.in(I_WGLU)[(size_t)k * 512 + n];
        const float ref = bf2f(Gb[(size_t)row * 512 + n]) * sigmoidf_(s);
        if (chk_cmp(bf2f(Mix[(size_t)row * 1024 + 512 + n]), ref, 0.2f)) chk_fail(c, 5);
    }
    const bf16_t* Qb = c.ws<bf16_t>(WS_Q); const bf16_t* Kb = c.ws<bf16_t>(WS_K); const bf16_t* Vt = c.ws<bf16_t>(WS_VT);
    for (int sidx = c.bid * 8 + c.wid; sidx < 1024; sidx += c.G * 8) {
        const unsigned hsh = hash_u(sidx * 2654435761u + 999u); const int b = hsh & 3, hd = (hsh >> 2) & 7, t = (hsh >> 8) & 4095, bh = b * NH + hd;
        const bf16_t* q = Qb + ((size_t)bh * SEQ + t) * 96;
        float mx = -1e30f;
        for (int j = 0; j < 68; ++j) { const int key = j * 64 + c.lane; const bf16_t* kp = Kb + ((size_t)bh * NKEY + key) * 96; float s = 0.f; for (int d = 0; d < 96; ++d) s += bf2f(q[d]) * bf2f(kp[d]); mx = fmaxf(mx, s); }
#pragma unroll
        for (int o = 1; o < 64; o <<= 1) mx = fmaxf(mx, __shfl_xor(mx, o));
        float l = 0.f, a[8];
#pragma unroll
        for (int dd = 0; dd < 8; ++dd) a[dd] = 0.f;
        const int dsel = (hsh >> 24) % 8;
        for (int j = 0; j < 68; ++j) { const int key = j * 64 + c.lane; const bf16_t* kp = Kb + ((size_t)bh * NKEY + key) * 96; float s = 0.f; for (int d = 0; d < 96; ++d) s += bf2f(q[d]) * bf2f(kp[d]);
            const float pe = exp2f(s - mx); l += pe;
#pragma unroll
            for (int dd = 0; dd < 8; ++dd) a[dd] += pe * bf2f(Vt[((size_t)bh * 64 + dd * 8 + dsel) * NKEY + keypos(key)]); }
        l = wave_sum(l);
#pragma unroll
        for (int dd = 0; dd < 8; ++dd) { const float av = wave_sum(a[dd]) / l;
            if (c.lane == 0 && chk_cmp(bf2f(Mix[(size_t)(b * SEQ + t) * 1024 + hd * 64 + dd * 8 + dsel]), av, 0.05f)) chk_fail(c, 6); }
    }
}
DI void chk_stage78(const Ctx& c) {
    LAS float* y1 = (LAS float*)c.lds;
    LAS float* red = y1 + 1024;
    const bf16_t* Mix = c.ws<bf16_t>(WS_MIX); const float* mod = c.ws<float>(WS_MOD);
    for (int sidx = c.bid; sidx < 256; sidx += c.G) {
        const int row = hash_u(sidx * 2654435761u + 31337u) % MLAT, b = row >> 12;
        __syncthreads();
        float sa = 0.f, ssv = 0.f;
        for (int k = c.tid; k < 512; k += NT) { const float a = bf2f(Mix[(size_t)row * 1024 + k]), s2 = bf2f(Mix[(size_t)row * 1024 + 512 + k]); sa += a * a; ssv += s2 * s2; }
        sa = wave_sum(sa); ssv = wave_sum(ssv);
        if (c.lane == 0) { red[c.wid] = sa; red[8 + c.wid] = ssv; }
        __syncthreads();
        float ta = 0.f, ts = 0.f; for (int w = 0; w < 8; ++w) { ta += red[w]; ts += red[8 + w]; }
        const float ra = rsqrtf(ta / 512.f + EPS), rsn = rsqrtf(ts / 512.f + EPS);
        for (int n = c.tid; n < 1024; n += NT) {
            float s = 0.f;
            for (int k = 0; k < 512; ++k) s += bf2f(Mix[(size_t)row * 1024 + k]) * ra * c.in(I_GNA)[k] * c.in(I_WO)[(size_t)k * 1024 + n];
            for (int k = 0; k < 512; ++k) s += bf2f(Mix[(size_t)row * 1024 + 512 + k]) * rsn * c.in(I_GNS)[k] * c.in(I_WO)[(size_t)(512 + k) * 1024 + n];
            y1[n] = ALPHA * c.in(I_X)[(size_t)row * 1024 + n] + mod[b * 6144 + 2048 + n] * s;
        }
        __syncthreads();
        float s1 = 0.f; for (int n = c.tid; n < 1024; n += NT) s1 += y1[n];
        s1 = wave_sum(s1); if (c.lane == 0) red[c.wid] = s1;
        __syncthreads();
        float mean = 0.f; for (int w = 0; w < 8; ++w) mean += red[w]; mean /= 1024.f;
        __syncthreads();
        float s2 = 0.f; for (int n = c.tid; n < 1024; n += NT) { const float dd = y1[n] - mean; s2 += dd * dd; }
        s2 = wave_sum(s2); if (c.lane == 0) red[c.wid] = s2;
        __syncthreads();
        float var = 0.f; for (int w = 0; w < 8; ++w) var += red[w]; var /= 1024.f;
        const float rstd = rsqrtf(var + EPS);
        for (int n = c.tid; n < 1024; n += NT) {
            const float x1 = (y1[n] - mean) * rstd * c.in(I_LN1G)[n] + c.in(I_LN1B)[n];
            const float hh = x1 * (1.f + mod[b * 6144 + 4096 + n]) + mod[b * 6144 + 3072 + n];
            if (chk_cmp(c.p.out[(size_t)row * 1024 + n], x1, 0.3f)) chk_fail(c, 7);
            if (chk_cmp(bf2f(c.ws<bf16_t>(WS_H)[(size_t)row * 1024 + n]), hh, 0.3f)) chk_fail(c, 7);
        }
    }
    __syncthreads();
    const int gt = c.bid * NT + c.tid, GT = c.G * NT;
    unsigned* ctl = c.ws<unsigned>(WS_CTL);
    if (gt == 0) { unsigned tot = 0; for (int e = 0; e < 32; ++e) tot += xb_ld(&ctl[CW_CNT + e]); if (tot != 2u * MLAT) chk_fail(c, 8); }
    for (int sidx = gt; sidx < 2048; sidx += GT) {
        const int e = sidx & 31; const int cnt = (int)xb_ld(&ctl[CW_CNT + e]); if (cnt == 0) continue;
        const int pos = hash_u(sidx * 2654435761u + 17u) % cnt; const int ts = c.ws<int>(WS_LIST)[e * 16384 + pos], row = ts >> 1, b = row >> 12;
        LAS float* lg = (LAS float*)(c.lds + 8192) + c.tid * 37; for (int q = 0; q < 36; ++q) lg[q] = q < 4 ? c.in(I_BRG)[q] : c.in(I_BRE2)[q - 4];
        for (int k = 0; k < 1024; ++k) { const float hh = c.p.out[(size_t)row * 1024 + k] * (1.f + mod[b * 6144 + 4096 + k]) + mod[b * 6144 + 3072 + k];
            for (int q = 0; q < 4; ++q) lg[q] += hh * c.in(I_WRG)[k * 4 + q];
            for (int q = 0; q < 32; ++q) lg[4 + q] += hh * c.in(I_WRE)[k * 32 + q]; }
        int gi = 0; for (int q = 1; q < 4; ++q) if (lg[q] > lg[gi]) gi = q;
        float gs = 0.f; for (int q = 0; q < 4; ++q) gs += expf(lg[q] - lg[gi]);
        if ((e >> 3) != gi) { float gap = lg[gi] - lg[e >> 3]; if (gap > 0.02f) chk_fail(c, 8); continue; }
        int better = 0; const float le = lg[4 + e]; float top1 = -1e30f, top2 = -1e30f;
        for (int q = 0; q < 8; ++q) { const float v = lg[4 + gi * 8 + q]; if (v > le + 0.02f) ++better; if (v > top1) { top2 = top1; top1 = v; } else if (v > top2) top2 = v; }
        if (better >= 2) chk_fail(c, 8);
        const float other = (fabsf(le - top1) < fabsf(le - top2)) ? top2 : top1;
        const float wref = (1.f / gs) / (1.f + expf(other - le));
        if (fabsf(c.ws<float>(WS_TOKW)[ts] - wref) > 0.03f) chk_fail(c, 8);
    }
}
DI void chk_stage9(const Ctx& c, const float* x1buf  ) {
    (void)x1buf;
}
#endif

__global__ void __launch_bounds__(NT, 2) mega(Params p) {
    extern __shared__ __attribute__((aligned(16))) unsigned char lds_raw[];
    Ctx c; c.p = p; c.lds = (LAS unsigned char*)lds_raw; c.tid = threadIdx.x; c.lane = c.tid & 63; c.wid = __builtin_amdgcn_readfirstlane(c.tid >> 6); c.bid = blockIdx.x; c.G = gridDim.x;
    volatile LAS unsigned* misc = (volatile LAS unsigned*)(c.lds + LDS_MISC);
    if (c.tid < 16) misc[c.tid] = 0u;
    __syncthreads();
    unsigned* ctl = c.ws<unsigned>(WS_CTL);
    XcdBarrier bar = xcd_barrier_post(ctl + CW_BAR, misc);
#define BAR() xcd_barrier(bar)
#if POISON_WS
    { u32x4* w = (u32x4*)(p.ws + 15 * MiB); const size_t n = (size_t)(241 * MiB) / 16; const u32x4 v = {0xffffffffu, 0xffffffffu, 0xffffffffu, 0xffffffffu};
      for (size_t i = (size_t)c.bid * NT + c.tid; i < n; i += (size_t)c.G * NT) w[i] = v; }
    BAR();
#endif
    stage_prep(c); BAR();
    stage_s1(c); BAR();
    stage_s2(c); BAR();
#if LAST_STAGE >= 3
    stage_inproj(c); BAR();
#if DEBUG_CHECK
    chk_stage12(c);
#endif
#endif
#if LAST_STAGE >= 4
    stage_upproj(c); BAR();
#if DEBUG_CHECK
    chk_stage3(c);
#endif
#endif
#if LAST_STAGE >= 5
    stage_carry(c); BAR();
    stage_ssmout(c); BAR();
#if DEBUG_CHECK
    chk_stage4(c);
#endif
#endif
#if LAST_STAGE >= 6
    stage_glu(c);
    stage_attn(c); BAR();
#if DEBUG_CHECK
    chk_stage56(c);
#endif
#endif
#if LAST_STAGE >= 7
    stage_wo(c); BAR();
    stage_ln1(c); BAR();
#if DEBUG_CHECK
    chk_stage78(c);
#endif
#endif
#if LAST_STAGE >= 8
    stage_expert<0>(c); BAR();
    stage_expert<1>(c); BAR();
    stage_final(c);
#endif
#if DEBUG_CHECK
    BAR();
    {
        const unsigned tmo = xb_ld(&ctl[CW_BAR + XB_TMO]);
        const unsigned chk = xb_ld(&ctl[CW_CHK]);
        float v = 0.f; bool fill = false;
        if (tmo) { v = 30.f; fill = true; }
        else if (chk) { v = (float)(64 - (int)chk); fill = true; }
        else if (LAST_STAGE < 8) { v = 20.f; fill = true; }
        if (fill) { const size_t n = (size_t)MLAT * 1024; for (size_t i = (size_t)c.bid * NT + c.tid; i < n; i += (size_t)c.G * NT) p.out[i] = v; }
    }
#endif
}

extern "C" void kernel_launch(void* const* d_in, const int* in_sizes, int n_in, void* d_out, int out_size, void* d_ws, size_t ws_size, hipStream_t stream) {
    static int grid = 0;
    if (grid == 0) {
        int dev = 0, cus = 0, per_cu = 0;
        (void)hipGetDevice(&dev);
        (void)hipDeviceGetAttribute(&cus, hipDeviceAttributeMultiprocessorCount, dev);
        (void)hipFuncSetAttribute((const void*)mega, hipFuncAttributeMaxDynamicSharedMemorySize, LDS_BYTES);
        (void)hipOccupancyMaxActiveBlocksPerMultiprocessor(&per_cu, (const void*)mega, NT, LDS_BYTES);
        (void)hipGetLastError();
        if (per_cu < 1) fprintf(stderr, "kernel_launch: occupancy query reports %d workgroups per CU\n", per_cu);
        if (ws_size < 256 * MiB) fprintf(stderr, "kernel_launch: workspace too small: %zu\n", ws_size);
        grid = cus > 0 ? cus : 256;
    }
    (void)hipMemsetAsync((char*)d_ws + WS_CTL, 0, 1 * MiB, stream);
    Params p{};
    for (int i = 0; i < N_IN && i < n_in; ++i) p.in[i] = (const float*)d_in[i];
    p.out = (float*)d_out; p.ws = (unsigned char*)d_ws;
    hipLaunchKernelGGL(mega, dim3(grid), dim3(NT), LDS_BYTES, stream, p);
}
```

```cpp
#include <hip/hip_runtime.h>
#include <cstdio>
#include <cstdint>


#define LAS __attribute__((address_space(3)))
#define DI __device__ __forceinline__
typedef unsigned short bf16_t;
typedef short bf16x8 __attribute__((ext_vector_type(8)));
typedef float f32x16 __attribute__((ext_vector_type(16)));
typedef float f32x4 __attribute__((ext_vector_type(4)));
typedef float f32x2 __attribute__((ext_vector_type(2)));
typedef __bf16 bf16x2n __attribute__((ext_vector_type(2)));
typedef unsigned u32x4 __attribute__((ext_vector_type(4)));
typedef unsigned u32x2 __attribute__((ext_vector_type(2)));

constexpr int NT = 512;
constexpr int LDS_BYTES = 163840;
constexpr int LDS_MISC = LDS_BYTES - 64;

constexpr int DM = 1024, NB = 4, SEQ = 4096, CTXL = 256, NH = 8;
constexpr int MLAT = NB * SEQ, MCTX = NB * CTXL, MALL = MLAT + MCTX;
constexpr int NKEY = SEQ + CTXL;
constexpr int NUNIT_B = NKEY / 16, NUNIT = NB * NUNIT_B;
constexpr float EPS = 1e-6f;
constexpr float ALPHA = 1.189207115002721f;
constexpr float QSCALE = 0.10206207261596577f * 1.4426950408889634f;

enum { I_X = 0, I_C, I_CTX, I_CCTX, I_WADA, I_BADA, I_WIN, I_QNG, I_KVNG, I_WUQ, I_WUKV, I_ARE, I_AIM, I_LOGDT, I_BRE, I_BIM, I_CRE, I_CIM,
       I_SSMD, I_WGLU, I_BGLU, I_GNA, I_GNS, I_WO, I_LN1G, I_LN1B, I_WRG, I_BRG, I_WRE, I_BRE2, I_WEG, I_WEU, I_WED, I_LN2G, I_LN2B, N_IN };

constexpr size_t MiB = 1u << 20;
constexpr size_t WS_CTL = 0;
constexpr size_t WS_MODP = 1 * MiB;
constexpr size_t WS_MOD = WS_MODP + 16 * 5 * 6144 * 4;
constexpr size_t WS_ROPEC = WS_MOD + 5 * 6144 * 4;
constexpr size_t WS_ROPES = WS_ROPEC + 4096 * 16 * 4;
constexpr size_t WS_PW = WS_ROPES + 4096 * 16 * 4;
constexpr size_t WS_BBAR = WS_PW + 64 * 64 * 20 * 8;
constexpr size_t WS_KC = WS_BBAR + 64 * 64 * 16 * 8;
constexpr size_t WS_WRT = WS_KC + 64 * 16 * 256 * 4;
constexpr size_t WS_TOKW = WS_WRT + 40 * 1024 * 4;
constexpr size_t WS_LIST = WS_TOKW + 16384 * 2 * 4;
constexpr size_t WS_WRH = WS_LIST + 32 * 16384 * 4;
constexpr size_t WS_WRL = WS_WRH + 64 * 1024 * 2;
constexpr size_t WS_STATS = WS_WRL + 64 * 1024 * 2;
constexpr size_t WS_SMALL_END = WS_STATS + 16384 * 2 * 4;
static_assert(WS_SMALL_END <= 9 * MiB, "small region");
constexpr size_t WS_WTIN = 9 * MiB;
constexpr size_t WS_WTO = 11 * MiB;
constexpr size_t WS_WTUQ = 13 * MiB;
constexpr size_t WS_WTUKV = WS_WTUQ + 768 * 256 * 2;
constexpr size_t WS_WTGLU = WS_WTUKV + 1024 * 128 * 2;
static_assert(WS_WTGLU + 512 * 512 * 2 <= 15 * MiB, "w region");
constexpr size_t WS_WEXP = 15 * MiB;
constexpr size_t WS_WGU = WS_WEXP, WS_WD = WS_WEXP + 32 * MiB;
constexpr size_t WS_M16 = 198 * MiB;
constexpr size_t WS_W3 = 248 * MiB;
constexpr size_t WS_ST = 63 * MiB;
constexpr size_t WS_XM = 63 * MiB;
constexpr size_t WS_P = 97 * MiB;
constexpr size_t WS_Q = 131 * MiB;
constexpr size_t WS_K = 155 * MiB;
constexpr size_t WS_KR = 173 * MiB;
constexpr size_t WS_VT = 181 * MiB;
constexpr size_t WS_G = 198 * MiB;
constexpr size_t WS_U2 = 114 * MiB;
constexpr size_t WS_MIX = 214 * MiB;
constexpr size_t WS_SSQP = 244 * MiB;
constexpr size_t WS_SSQA = 246 * MiB;
constexpr size_t WS_SSQS = 247 * MiB;
constexpr size_t WS_Y1B = 181 * MiB;
constexpr size_t WS_H = 63 * MiB;
constexpr size_t WS_Z = 97 * MiB;
constexpr size_t WS_F = 113 * MiB;
static_assert(WS_MIX + 32 * MiB <= 256 * MiB && WS_F + 64 * MiB <= WS_VT, "ws map");
constexpr int CW_CHK = 16, CW_CNT = 8192  , CW_BAR = 4096;
#define CNT_IDX(e) (CW_CNT + 64 * (e))
constexpr int CW_BGHEAD = 12288, CW_BGDONE = 12288 + 64;

struct Params { const float* in[N_IN]; float* out; unsigned char* ws; };

#define XB_TMO      128
#define XB_XCNT(j)  (256  + 64 * (j))
#define XB_XSUB(j)  (1280 + 64 * (j))
#define XB_XGEN(j)  (2304 + 64 * (j))
#define XB_TOP      3328
#define XB_TOPGEN   3392
#define XCD_BAR_WORDS 3456
#define XB_SPIN_CAP (1u << 18)
DI unsigned xb_ld(unsigned* p)              { return __hip_atomic_load(p, __ATOMIC_RELAXED, __HIP_MEMORY_SCOPE_AGENT); }
DI unsigned xb_add(unsigned* p, unsigned v) { return __hip_atomic_fetch_add(p, v, __ATOMIC_RELAXED, __HIP_MEMORY_SCOPE_AGENT); }
DI unsigned xb_xcc_id() { return (unsigned)__builtin_amdgcn_s_getreg((3 << 11) | 20) & 0xFu; }
#define XB_SPIN(cond, bar) do { unsigned _sp = 0; while (cond) { __builtin_amdgcn_s_sleep(1); \
    if ((++_sp & 255u) == 0u) { if (xb_ld(&(bar)[XB_TMO])) break; if (_sp > XB_SPIN_CAP) { atomicAdd(&(bar)[XB_TMO], 1u); break; } } } } while (0)
struct XcdBarrier { unsigned* bar; unsigned x; volatile LAS unsigned* st; };
DI XcdBarrier xcd_barrier_post(unsigned* bar, volatile LAS unsigned* st) {
    XcdBarrier b; b.bar = bar; b.x = xb_xcc_id(); b.st = st;
    if (threadIdx.x == 0) (void)xb_add(&bar[XB_XCNT(b.x)], 1u);
    return b;
}
DI void xcd_barrier_complete(unsigned* bar, unsigned x, unsigned& nloc, unsigned& nx) {
    const unsigned G = gridDim.x * gridDim.y * gridDim.z;
    unsigned sum, cnt, mine, sp = 0u;
    for (;;) {
        sum = 0u; cnt = 0u; mine = 0u;
#pragma unroll
        for (unsigned j = 0; j < 16; ++j) { const unsigned c = xb_ld(&bar[XB_XCNT(j)]); sum += c; cnt += (c > 0u) ? 1u : 0u; mine = (j == x) ? c : mine; }
        if (sum == G) break;
        __builtin_amdgcn_s_sleep(1);
        if ((++sp & 255u) == 0u) { if (xb_ld(&bar[XB_TMO])) break; if (sp > XB_SPIN_CAP) { atomicAdd(&bar[XB_TMO], 1u); break; } }
    }
    nloc = mine > 0u ? mine : 1u; nx = cnt > 0u ? cnt : 1u;
}
DI void xcd_barrier(const XcdBarrier& b) {
    asm volatile("s_waitcnt vmcnt(0)" ::: "memory");
    __syncthreads();
    if (threadIdx.x == 0) {
        unsigned* bar = b.bar;
        __builtin_amdgcn_s_waitcnt(0);
        unsigned nloc = b.st[0], nx = b.st[1];
        if (nloc == 0u) { xcd_barrier_complete(bar, b.x, nloc, nx); b.st[0] = nloc; b.st[1] = nx; }
        const unsigned old = xb_add(&bar[XB_XSUB(b.x)], 1u);
        const unsigned gen = old / nloc;
        if (old + 1u == (gen + 1u) * nloc) {
            __builtin_amdgcn_fence(__ATOMIC_RELEASE, "agent");
            asm volatile("s_waitcnt vmcnt(0)" ::: "memory");
            const unsigned og = xb_add(&bar[XB_TOP], 1u);
            const unsigned tg = og / nx;
            if (og + 1u == (tg + 1u) * nx) xb_add(&bar[XB_TOPGEN], 1u);
            else XB_SPIN(xb_ld(&bar[XB_TOPGEN]) == tg, bar);
            __builtin_amdgcn_fence(__ATOMIC_ACQUIRE, "agent");
            xb_add(&bar[XB_XGEN(b.x)], 1u);
            asm volatile("s_waitcnt vmcnt(0)" ::: "memory");
        } else {
            XB_SPIN(xb_ld(&bar[XB_XGEN(b.x)]) == gen, bar);
            __builtin_amdgcn_fence(__ATOMIC_ACQUIRE, "agent");
            asm volatile("s_waitcnt vmcnt(0)" ::: "memory");
        }
    }
    __syncthreads();
}

DI float bf2f(bf16_t u) { return __uint_as_float((unsigned)u << 16); }
DI bf16_t f2bf(float f) { unsigned u = __float_as_uint(f); return (bf16_t)((u + 0x7fffu + ((u >> 16) & 1u)) >> 16); }
DI unsigned pk2(float lo, float hi) { f32x2 v = {lo, hi}; bf16x2n r = __builtin_convertvector(v, bf16x2n); return __builtin_bit_cast(unsigned, r); }
DI float lo16(unsigned u) { return __uint_as_float(u << 16); }
DI float hi16(unsigned u) { return __uint_as_float(u & 0xffff0000u); }
DI float wave_sum(float v) {
#pragma unroll
    for (int o = 1; o < 64; o <<= 1) v += __shfl_xor(v, o);
    return v;
}
template <int CTRL> DI float dpp_f(float v) { return __int_as_float(__builtin_amdgcn_update_dpp(0, __float_as_int(v), CTRL, 0xF, 0xF, false)); }
DI float wave_sum_fast(float v) {
    v += dpp_f<0xB1>(v);
    v += dpp_f<0x4E>(v);
    v += dpp_f<0x141>(v);
    v += dpp_f<0x140>(v);
    return __int_as_float(__builtin_amdgcn_readlane(__float_as_int(v), 0)) + __int_as_float(__builtin_amdgcn_readlane(__float_as_int(v), 16)) +
           __int_as_float(__builtin_amdgcn_readlane(__float_as_int(v), 32)) + __int_as_float(__builtin_amdgcn_readlane(__float_as_int(v), 48));
}
DI float sigmoidf_(float x) { return __builtin_amdgcn_rcpf(1.f + __builtin_amdgcn_exp2f(-1.4426950408889634f * x)); }
DI float siluf_(float x) { return x * sigmoidf_(x); }
DI float geluf_(float x) { const float z2 = 1.5957691216057308f * (x + 0.044715f * x * x * x); return x * __builtin_amdgcn_rcpf(1.f + __builtin_amdgcn_exp2f(-1.4426950408889634f * z2)); }
DI int keypos(int key) { const int o = key & 15; return (key & ~15) | ((o & 3) + 4 * ((o >> 3) & 1) + 8 * ((o >> 2) & 1)); }
DI int unit_row0(int u) { const int b = u / NUNIT_B, c = u % NUNIT_B; return c < 16 ? MLAT + b * CTXL + 16 * c : b * SEQ + 16 * (c - 16); }

struct Ctx {
    Params p; LAS unsigned char* lds; int tid, lane, wid, bid, G, vb;
    DI const float* in(int i) const { return p.in[i]; }
    template <class T> DI T* ws(size_t off) const { return (T*)(p.ws + off); }
};

constexpr int GBM = 256, GBN = 128, GROW = 128, G_ASTAGE = GBM * GROW, G_WSTAGE = GBN * GROW, G_STAGE = G_ASTAGE + G_WSTAGE;
constexpr int G_SCR = 3 * G_STAGE;
#define MFMA32(a, b, c) __builtin_amdgcn_mfma_f32_32x32x16_bf16((a), (b), (c), 0, 0, 0)

#define GLDS16(gp, lp) __builtin_amdgcn_global_load_lds((const unsigned*)(gp), (LAS unsigned*)(lp), 16, 0, 0)
#define RAW_BARRIER() do { asm volatile("s_waitcnt lgkmcnt(0)" ::: "memory"); __builtin_amdgcn_s_barrier(); } while (0)
template <int PROBE = 0, class AL, class WL, class EPI>
DI void gemm_tile(const Ctx& c, AL& al, WL& wl, int m0, int n0, int K, EPI& epi, const LAS float* midscale, int midk) {
    const int lane = c.lane, wid = c.wid, r = lane & 31, h = lane >> 5, wm = wid & 3, wn = wid >> 2;
    f32x16 acc[2][2];
#pragma unroll
    for (int i = 0; i < 2; ++i)
#pragma unroll
        for (int j = 0; j < 2; ++j)
#pragma unroll
            for (int e = 0; e < 16; ++e) acc[i][j][e] = 0.f;
    const int l8 = lane >> 3, p8 = lane & 7;
    int ak[4], wk[2];
#pragma unroll
    for (int i = 0; i < 4; ++i) { const int row = wid * 32 + i * 8 + l8; al.init(i, m0 + row); ak[i] = (p8 ^ ((row >> 1) & 7)) * 8; }
#pragma unroll
    for (int i = 0; i < 2; ++i) { const int row = wid * 16 + i * 8 + l8; wl.init(i, n0 + row); wk[i] = (p8 ^ ((row >> 1) & 7)) * 8; }
    LAS unsigned char* ldA = c.lds + wid * 32 * GROW;
    LAS unsigned char* ldW = c.lds + G_ASTAGE + wid * 16 * GROW;
    const int nk = K / 64;
#define GEMM_ISSUE(KT, BUF)                                                                                            \
    { const int k0_ = (KT) * 64; LAS unsigned char* a_ = ldA + (BUF) * G_STAGE; LAS unsigned char* w_ = ldW + (BUF) * G_STAGE; \
      _Pragma("unroll") for (int i = 0; i < 4; ++i) GLDS16(al.ptr(i, k0_ + ak[i]), a_ + i * 8 * GROW);                \
      _Pragma("unroll") for (int i = 0; i < 2; ++i) GLDS16(wl.ptr(i, k0_ + wk[i]), w_ + i * 8 * GROW); }
    const int sx = (r >> 1) & 7;
    int fo[4];
#pragma unroll
    for (int ks = 0; ks < 4; ++ks) fo[ks] = ((2 * ks + h) ^ sx) * 16;
    const LAS unsigned char* sa0 = c.lds + (wm * 64 + r) * GROW;
    const LAS unsigned char* sw0 = c.lds + G_ASTAGE + (wn * 64 + r) * GROW;
    RAW_BARRIER();
    GEMM_ISSUE(0, 0)
    GEMM_ISSUE(1, 1)
    int buf = 0;
    bf16x8 pf_w = {1, 2, 3, 4, 5, 6, 7, 8}, pf_a = {8, 7, 6, 5, 4, 3, 2, 1};
    for (int kt = 0; kt < nk; ++kt) {
        if (kt + 1 < nk) asm volatile("s_waitcnt vmcnt(6)" ::: "memory"); else asm volatile("s_waitcnt vmcnt(0)" ::: "memory");
        RAW_BARRIER();
        if (!(PROBE & 1) && kt + 2 < nk) { const int nb = buf == 0 ? 2 : buf - 1; GEMM_ISSUE(kt + 2, nb) }
        const LAS unsigned char* sa = sa0 + ((PROBE & 2) ? 0 : buf) * G_STAGE; const LAS unsigned char* sw = sw0 + ((PROBE & 2) ? 0 : buf) * G_STAGE;
        if ((PROBE & 2) && kt > 0) { _Pragma("unroll") for (int q = 0; q < 16; ++q) { acc[0][0] = MFMA32(pf_w, pf_a, acc[0][0]); } asm volatile("" : "+v"(pf_w), "+v"(pf_a)); buf = buf == 2 ? 0 : buf + 1; continue; }
#pragma unroll
        for (int ks = 0; ks < 4; ++ks) {
            const bf16x8 a0 = *(const LAS bf16x8*)(sa + fo[ks]), a1 = *(const LAS bf16x8*)(sa + 32 * GROW + fo[ks]);
            const bf16x8 w0 = *(const LAS bf16x8*)(sw + fo[ks]), w1 = *(const LAS bf16x8*)(sw + 32 * GROW + fo[ks]);
            acc[0][0] = MFMA32(w0, a0, acc[0][0]); acc[0][1] = MFMA32(w0, a1, acc[0][1]);
            acc[1][0] = MFMA32(w1, a0, acc[1][0]); acc[1][1] = MFMA32(w1, a1, acc[1][1]);
        }
        if (midscale != nullptr && kt == midk) {
            const float s0 = midscale[wm * 64 + r], s1 = midscale[wm * 64 + 32 + r];
#pragma unroll
            for (int e = 0; e < 16; ++e) { acc[0][0][e] *= s0; acc[1][0][e] *= s0; acc[0][1][e] *= s1; acc[1][1][e] *= s1; }
        }
        buf = buf == 2 ? 0 : buf + 1;
    }
#undef GEMM_ISSUE
    if constexpr (EPI::STAGED) {
        if (!(PROBE & 4)) {
            RAW_BARRIER();
            LAS float* reg = (LAS float*)(c.lds + wid * 17408);
#pragma unroll
            for (int im = 0; im < 2; ++im)
#pragma unroll
                for (int in = 0; in < 2; ++in)
#pragma unroll
                    for (int g = 0; g < 4; ++g) *(LAS f32x4*)(reg + (im * 32 + r) * 68 + in * 32 + 8 * g + 4 * h) = (f32x4){acc[in][im][4 * g], acc[in][im][4 * g + 1], acc[in][im][4 * g + 2], acc[in][im][4 * g + 3]};
            asm volatile("s_waitcnt lgkmcnt(0)" ::: "memory");
            const int rr = lane >> 4, cc = (lane & 15) * 4;
            if constexpr (EPI::STAGED == 2) { epi.staged(reg, lane, m0 + wm * 64, n0 + wn * 64, wm * 64); } else
#pragma unroll 4
            for (int j = 0; j < 16; ++j) { const int row = 4 * j + rr; const f32x4 v = *(const LAS f32x4*)(reg + row * 68 + cc);
                epi.chunk(m0 + wm * 64 + row, n0 + wn * 64 + cc, v, wm * 64 + row); }
        }
    } else {
        if (!(PROBE & 4)) epi.run(acc, m0 + wm * 64 + r, n0 + wn * 64, h, wm * 64 + r);
    }
    if (false) {}
    else { asm volatile("" :: "v"(acc[0][0]), "v"(acc[0][1]), "v"(acc[1][0]), "v"(acc[1][1])); }
}

constexpr int H_ROW = 64, H_ASTAGE = 256 * H_ROW, H_STAGE = 2 * H_ASTAGE;
template <class EPI>
DI void gemm_tile256(const Ctx& c, const bf16_t* A, int lda, const bf16_t* W, int ldw, int m0, int n0, int K, EPI& epi, const LAS float* midscale, int midk) {
    const int lane = c.lane, wid = c.wid, r = lane & 31, h = lane >> 5, wm = wid & 1, wn = wid >> 1;
    f32x16 acc[2][4];
#pragma unroll
    for (int i = 0; i < 2; ++i)
#pragma unroll
        for (int j = 0; j < 4; ++j)
#pragma unroll
            for (int e = 0; e < 16; ++e) acc[i][j][e] = 0.f;
    const int prow = lane >> 2, ppos = lane & 3;
    const bf16_t* asrc[2]; const bf16_t* wsrc[2];
#pragma unroll
    for (int i = 0; i < 2; ++i) { const int row = (2 * wid + i) * 16 + prow; const int ch = ppos ^ ((row >> 2) & 3);
        asrc[i] = A + (size_t)(m0 + row) * lda + ch * 8; wsrc[i] = W + (size_t)(n0 + row) * ldw + ch * 8; }
    LAS unsigned char* ldA = c.lds + (2 * wid) * 1024;
    LAS unsigned char* ldW = c.lds + H_ASTAGE + (2 * wid) * 1024;
    const int nk = K / 32;
#define H_ISSUE(KT, BUF) { const int k0_ = (KT) * 32; LAS unsigned char* a_ = ldA + (BUF) * H_STAGE; LAS unsigned char* w_ = ldW + (BUF) * H_STAGE; \
      GLDS16(asrc[0] + k0_, a_); GLDS16(asrc[1] + k0_, a_ + 1024); GLDS16(wsrc[0] + k0_, w_); GLDS16(wsrc[1] + k0_, w_ + 1024); }
    const int sx = (r >> 2) & 3;
    const int fo0 = ((0 + h) ^ sx) * 16, fo1 = ((2 + h) ^ sx) * 16;
    const LAS unsigned char* sa0 = c.lds + (wm * 128 + r) * H_ROW;
    const LAS unsigned char* sw0 = c.lds + H_ASTAGE + (wn * 64 + r) * H_ROW;
    RAW_BARRIER();
    H_ISSUE(0, 0) H_ISSUE(1, 1) H_ISSUE(2, 2)
    int buf = 0;
    for (int kt = 0; kt < nk; ++kt) {
        if (kt + 2 < nk) asm volatile("s_waitcnt vmcnt(8)" ::: "memory"); else if (kt + 1 < nk) asm volatile("s_waitcnt vmcnt(4)" ::: "memory"); else asm volatile("s_waitcnt vmcnt(0)" ::: "memory");
        RAW_BARRIER();
        if (kt + 3 < nk) { const int nb = (buf + 3) & 3; H_ISSUE(kt + 3, nb) }
        const LAS unsigned char* sa = sa0 + buf * H_STAGE; const LAS unsigned char* sw = sw0 + buf * H_STAGE;
#pragma unroll
        for (int ks = 0; ks < 2; ++ks) {
            const int fo = ks ? fo1 : fo0;
            bf16x8 af[4], wf[2];
#pragma unroll
            for (int im = 0; im < 4; ++im) af[im] = *(const LAS bf16x8*)(sa + im * 32 * H_ROW + fo);
#pragma unroll
            for (int in = 0; in < 2; ++in) wf[in] = *(const LAS bf16x8*)(sw + in * 32 * H_ROW + fo);
#pragma unroll
            for (int in = 0; in < 2; ++in)
#pragma unroll
                for (int im = 0; im < 4; ++im) acc[in][im] = MFMA32(wf[in], af[im], acc[in][im]);
        }
        if (midscale != nullptr && kt == midk) {
#pragma unroll
            for (int im = 0; im < 4; ++im) { const float s = midscale[wm * 128 + im * 32 + r];
#pragma unroll
                for (int e = 0; e < 16; ++e) { acc[0][im][e] *= s; acc[1][im][e] *= s; } }
        }
        buf = (buf + 1) & 3;
    }
#undef H_ISSUE
    LAS float* reg = (LAS float*)(c.lds + wid * 17408);
    const int rr = lane >> 4, cc = (lane & 15) * 4;
#pragma unroll
    for (int hf = 0; hf < 2; ++hf) {
        RAW_BARRIER();
#pragma unroll
        for (int q = 0; q < 2; ++q)
#pragma unroll
            for (int in = 0; in < 2; ++in)
#pragma unroll
                for (int g = 0; g < 4; ++g) { const f32x16& v = acc[in][hf * 2 + q];
                    *(LAS f32x4*)(reg + (q * 32 + r) * 68 + in * 32 + 8 * g + 4 * h) = (f32x4){v[4 * g], v[4 * g + 1], v[4 * g + 2], v[4 * g + 3]}; }
        asm volatile("s_waitcnt lgkmcnt(0)" ::: "memory");
#pragma unroll 4
        for (int j = 0; j < 16; ++j) { const int row = 4 * j + rr; const f32x4 v = *(const LAS f32x4*)(reg + row * 68 + cc);
            epi.chunk(m0 + wm * 128 + hf * 64 + row, n0 + wn * 64 + cc, v, wm * 128 + hf * 64 + row); }
    }
}

template <int NR> struct RowLoader {
    const bf16_t* base; int ld, nrows; const bf16_t* rp[NR];
    DI void init(int i, int row) { rp[i] = base + (size_t)(row < nrows ? row : nrows - 1) * ld; }
    DI const bf16_t* ptr(int i, int k) const { return rp[i] + k; }
};

DI int maprow(int mode, int j) {
    if (mode == 1) return j < 416 ? j : j + 96;
    if (mode == 2) return 64 * (j >> 5) + (j & 31);
    if (mode == 3) return 64 * (j >> 5) + 32 + (j & 31);
    return j;
}
DI void tr_tile(const Ctx& c, const float* src, int ldsrc, int k0, int j0, bf16_t* dst, int lddst, int mode, const float* gain) {
    LAS float* scr = (LAS float*)c.lds;
    __syncthreads();
    {
        const int jj = c.tid & 63;
        const bool ok = (j0 + jj) < ldsrc;
#pragma unroll
        for (int i = 0; i < 8; ++i) {
            const int kk = i * 8 + (c.tid >> 6);
            float v = ok ? src[(size_t)(k0 + kk) * ldsrc + j0 + jj] : 0.f;
            if (gain) v *= gain[k0 + kk];
            scr[kk * 65 + jj] = v;
        }
    }
    __syncthreads();
    {
        const int jj = c.tid >> 3, kc = c.tid & 7;
        if (j0 + jj < ldsrc) {
            const LAS float* s = scr + (kc * 8) * 65 + jj;
            u32x4 o; o.x = pk2(s[0], s[65]); o.y = pk2(s[2 * 65], s[3 * 65]); o.z = pk2(s[4 * 65], s[5 * 65]); o.w = pk2(s[6 * 65], s[7 * 65]);
            *(u32x4*)(dst + (size_t)maprow(mode, j0 + jj) * lddst + k0 + kc * 8) = o;
        }
    }
}

DI void stage_prep(const Ctx& c) {
    constexpr int N_MODP = 16 * 12, N_ROPE = 128, N_SSM0 = 8, N_WIN = 16 * 15, N_WO = 256, N_WUQ = 4 * 12, N_WUKV = 2 * 16, N_WGLU = 64, N_RT = 64, N_MISC = 1;
    constexpr int TOT = N_MODP + N_ROPE + N_SSM0 + N_WIN + N_WO + N_WUQ + N_WUKV + N_WGLU + N_RT + N_MISC;
    for (int it0 = c.bid; it0 < TOT; it0 += c.G) {
        int it = it0;
        if (it < N_MODP) {
            const int kc = it / 12, jb = it % 12;
            LAS float* sv = (LAS float*)c.lds;
            __syncthreads();
            if (c.tid < 320) { const int r = c.tid / 64, k = kc * 64 + (c.tid & 63); const float v = r < 4 ? c.in(I_C)[r * 1024 + k] : c.in(I_CCTX)[k]; sv[c.tid] = siluf_(v); }
            __syncthreads();
            const int j = jb * 512 + c.tid;
            float a0 = 0.f, a1 = 0.f, a2 = 0.f, a3 = 0.f, a4 = 0.f;
            const float* w = c.in(I_WADA) + (size_t)(kc * 64) * 6144 + j;
            float wv[64];
#pragma unroll
            for (int k = 0; k < 64; ++k) wv[k] = w[(size_t)k * 6144];
#pragma unroll
            for (int k = 0; k < 64; ++k) { a0 += sv[k] * wv[k]; a1 += sv[64 + k] * wv[k]; a2 += sv[128 + k] * wv[k]; a3 += sv[192 + k] * wv[k]; a4 += sv[256 + k] * wv[k]; }
            float* mp = c.ws<float>(WS_MODP) + (size_t)kc * 5 * 6144 + j;
            mp[0] = a0; mp[6144] = a1; mp[2 * 6144] = a2; mp[3 * 6144] = a3; mp[4 * 6144] = a4;
            continue;
        }
        it -= N_MODP;
        if (it < N_ROPE) {
            const int idx = it * 512 + c.tid, t = idx >> 4, i = idx & 15;
            const int pos = (i < 8) ? (t >> 6) : (t & 63);
            const float inv = exp2f(-(float)(i & 7) * (13.287712379549449f / 8.0f));
            const float ang = (float)pos * inv;
            float sn, cs; sincosf(ang, &sn, &cs);
            c.ws<float>(WS_ROPEC)[idx] = cs; c.ws<float>(WS_ROPES)[idx] = sn;
            continue;
        }
        it -= N_ROPE;
        if (it < N_SSM0) {
            const int idx = it * 512 + c.tid, dg = idx >> 6, p = idx & 63;
            const double are = c.in(I_ARE)[idx], aim = c.in(I_AIM)[idx], dt = exp((double)c.in(I_LOGDT)[dg]);
            float2* pw = c.ws<float2>(WS_PW) + (size_t)idx * 20;
            const double mag = exp(are * dt), abr = mag * cos(aim * dt), abi = mag * sin(aim * dt);
            { double pr = 1.0, pi = 0.0; for (int k = 0; k <= 16; ++k) { pw[k] = make_float2((float)pr, (float)pi); const double nr = pr * abr - pi * abi, ni = pr * abi + pi * abr; pr = nr; pi = ni; } }
            const double den = are * are + aim * aim, nre = abr - 1.0;
            const double cre = (nre * are + abi * aim) / den, cim = (abi * are - nre * aim) / den;
            float2* bb = c.ws<float2>(WS_BBAR) + (size_t)idx * 16;
            for (int hh = 0; hh < 16; ++hh) { const double br = c.in(I_BRE)[(size_t)idx * 16 + hh], bi = c.in(I_BIM)[(size_t)idx * 16 + hh];
                bb[hh] = make_float2((float)(cre * br - cim * bi), (float)(cre * bi + cim * br)); }
            continue;
        }
        it -= N_SSM0;
        if (it < N_WIN) { const int kb = it / 15, jb = it % 15; tr_tile(c, c.in(I_WIN), 928, kb * 64, jb * 64, c.ws<bf16_t>(WS_WTIN), 1024, 1, nullptr); continue; }
        it -= N_WIN;
        if (it < N_WO) { const int kb = it / 16, jb = it % 16; tr_tile(c, c.in(I_WO), 1024, kb * 64, jb * 64, c.ws<bf16_t>(WS_WTO), 1024, 0, kb < 8 ? c.in(I_GNA) : c.in(I_GNS) - 512); continue; }
        it -= N_WO;
        if (it < N_WUQ) { const int kb = it / 12, jb = it % 12; tr_tile(c, c.in(I_WUQ), 768, kb * 64, jb * 64, c.ws<bf16_t>(WS_WTUQ), 256, 0, c.in(I_QNG)); continue; }
        it -= N_WUQ;
        if (it < N_WUKV) { const int kb = it / 16, jb = it % 16; tr_tile(c, c.in(I_WUKV), 1024, kb * 64, jb * 64, c.ws<bf16_t>(WS_WTUKV), 128, 0, c.in(I_KVNG)); continue; }
        it -= N_WUKV;
        if (it < N_WGLU) { const int kb = it / 8, jb = it % 8; tr_tile(c, c.in(I_WGLU), 512, kb * 64, jb * 64, c.ws<bf16_t>(WS_WTGLU), 512, 0, nullptr); continue; }
        it -= N_WGLU;
        if (it < N_RT) {
            const int e = it;
#pragma unroll
            for (int q = 0; q < 2; ++q) { const int k = c.tid + q * 512; const float w = e < 4 ? c.in(I_WRG)[k * 4 + e] : (e < 36 ? c.in(I_WRE)[k * 32 + (e - 4)] : 0.f);
                const bf16_t hi = f2bf(w); c.ws<bf16_t>(WS_WRH)[e * 1024 + k] = hi; c.ws<bf16_t>(WS_WRL)[e * 1024 + k] = f2bf(w - bf2f(hi));
            }
            continue;
        }
        it -= N_RT;
        {
            bf16_t* wt = c.ws<bf16_t>(WS_WTIN);
            for (int i = c.tid; i < 96 * 1024 / 8; i += NT) ((u32x4*)(wt + 416 * 1024))[i] = (u32x4){0u, 0u, 0u, 0u};
        }
    }
}

DI void stage_s1(const Ctx& c) {
    const int gt = c.bid * NT + c.tid, GT = c.G * NT;
    for (int i = gt; i < 5 * 6144; i += GT) {
        const int j = i % 6144; float s = c.in(I_BADA)[j];
#pragma unroll
        for (int kc = 0; kc < 16; ++kc) s += c.ws<float>(WS_MODP)[(size_t)kc * 5 * 6144 + i];
        c.ws<float>(WS_MOD)[i] = s;
    }
    {
        const float* modp = c.ws<float>(WS_MODP);
        const int rpb = (MALL + c.G - 1) / c.G, r0 = c.bid * rpb, r1 = (r0 + rpb < MALL) ? r0 + rpb : MALL;
        if (r0 < MALL) {
            const int mrA = r0 < MLAT ? r0 / SEQ : 4, mrB = (r1 - 1) < MLAT ? (r1 - 1) / SEQ : 4;
            LAS float* mv = (LAS float*)(c.lds + 32768);
            __syncthreads();
            for (int idx = c.tid; idx < 4096; idx += NT) { const int set = idx >> 11, which = (idx >> 10) & 1, n = idx & 1023, mr = set ? mrB : mrA, col = which * 1024 + n;
                float s = c.in(I_BADA)[col] + (which ? 1.f : 0.f);
#pragma unroll
                for (int kc = 0; kc < 16; ++kc) s += modp[(size_t)(kc * 5 + mr) * 6144 + col];
                mv[idx] = s; }
            __syncthreads();
            for (int rb = r0 + c.wid; rb < r1; rb += 24) {
                f32x4 v[3][4];
#pragma unroll
                for (int q = 0; q < 3; ++q) { const int row = rb + 8 * q; if (row < r1) {
                    const float* src = row < MLAT ? c.in(I_X) + (size_t)row * 1024 : c.in(I_CTX) + (size_t)(row - MLAT) * 1024;
#pragma unroll
                    for (int j = 0; j < 4; ++j) v[q][j] = *(const f32x4*)(src + (c.lane + 64 * j) * 4); } }
#pragma unroll
                for (int q = 0; q < 3; ++q) { const int row = rb + 8 * q; if (row < r1) {
                    const int mr = row < MLAT ? row / SEQ : 4; const LAS float* ms = mv + (mr == mrA ? 0 : 2048);
                    bf16_t* dst = c.ws<bf16_t>(WS_XM) + (size_t)row * 1024;
#pragma unroll
                    for (int j = 0; j < 4; ++j) { const int n = (c.lane + 64 * j) * 4;
                        const f32x4 sh = *(const LAS f32x4*)(ms + n), sc = *(const LAS f32x4*)(ms + 1024 + n), x = v[q][j] * sc + sh;
                        u32x2 o; o.x = pk2(x.x, x.y); o.y = pk2(x.z, x.w); *(u32x2*)(dst + n) = o; } } }
            }
        }
    }
    const float2* pw = c.ws<float2>(WS_PW); const float2* bbar = c.ws<float2>(WS_BBAR);
#pragma unroll 4
    for (int i = gt; i < 32 * 256 * 256 / 2; i += GT) {
        float v2[2];
#pragma unroll
        for (int q = 0; q < 2; ++q) { const int ii = 2 * i + q, k = ii & 255, n = (ii >> 8) & 255, g = ii >> 16;
            const int d = n >> 7, ri = (n >> 6) & 1, p = n & 63, j = k >> 4, hp = k & 15, dg = d * 32 + g, e = d ? j : 15 - j;
            const float2 a = pw[(size_t)(dg * 64 + p) * 20 + e], b = bbar[(size_t)(dg * 64 + p) * 16 + hp];
            v2[q] = ri ? (a.x * b.y + a.y * b.x) : (a.x * b.x - a.y * b.y); }
        c.ws<unsigned>(WS_M16)[i] = pk2(v2[0], v2[1]);
    }
    LAS f32x2* lpw = (LAS f32x2*)c.lds;
    LAS f32x2* lbb = lpw + 256;
    LAS float* lcr = (LAS float*)(lbb + 1024);
    LAS float* lci = lcr + 1024;
    for (int it = c.bid; it < 256; it += c.G) {
        const int dg = it >> 2, lq = it & 3;
        __syncthreads();
        if (c.tid < 256) { const int p = c.tid >> 2, l = c.tid & 3; const float2 a = pw[(size_t)(dg * 64 + p) * 20 + lq * 4 + l]; lpw[c.tid] = (f32x2){a.x, a.y}; }
        for (int i = c.tid; i < 1024; i += NT) { const float2 b = bbar[(size_t)dg * 1024 + i]; lbb[i] = (f32x2){b.x, b.y}; lcr[i] = c.in(I_CRE)[(size_t)dg * 1024 + i]; lci[i] = c.in(I_CIM)[(size_t)dg * 1024 + i]; }
        __syncthreads();
#pragma unroll
        for (int q = 0; q < 2; ++q) {
            const int i = c.tid + q * 512, hp = i & 15, hh = (i >> 4) & 15, l = i >> 8;
            float s = 0.f;
#pragma unroll 16
            for (int p = 0; p < 64; ++p) { const f32x2 a = lpw[p * 4 + l], b = lbb[p * 16 + hp];
                s += lcr[hh * 64 + p] * (a.x * b.x - a.y * b.y) - lci[hh * 64 + p] * (a.x * b.y + a.y * b.x); }
            c.ws<float>(WS_KC)[(size_t)(dg * 16 + lq * 4 + l) * 256 + hh * 16 + hp] = s;
        }
    }
}

template <int PROBE = 0> DI void inproj_tile(const Ctx& c, int mt, int nt);
DI void xm_rows3(const Ctx& c, int row0, int stride, int lim) {
    const float* mod = c.ws<float>(WS_MOD);
    f32x4 v[3][4];
#pragma unroll
    for (int q = 0; q < 3; ++q) { const int row = row0 + q * stride; if (row < lim) {
        const float* src = row < MLAT ? c.in(I_X) + (size_t)row * 1024 : c.in(I_CTX) + (size_t)(row - MLAT) * 1024;
#pragma unroll
        for (int j = 0; j < 4; ++j) v[q][j] = *(const f32x4*)(src + (c.lane + 64 * j) * 4); } }
#pragma unroll
    for (int q = 0; q < 3; ++q) { const int row = row0 + q * stride; if (row < lim) {
        const int mr = row < MLAT ? row / SEQ : 4;
        const float* sh = mod + (size_t)mr * 6144, * sc = sh + 1024;
        bf16_t* dst = c.ws<bf16_t>(WS_XM) + (size_t)row * 1024;
#pragma unroll
        for (int j = 0; j < 4; ++j) {
            const int n = (c.lane + 64 * j) * 4;
            const f32x4 a = *(const f32x4*)(sc + n), b = *(const f32x4*)(sh + n), x = v[q][j];
            u32x2 o; o.x = pk2(x.x * (1.f + a.x) + b.x, x.y * (1.f + a.y) + b.y); o.y = pk2(x.z * (1.f + a.z) + b.z, x.w * (1.f + a.w) + b.w);
            *(u32x2*)(dst + n) = o;
        } } }
}
DI void w3_chunk(const Ctx& c, int chunk) {
    const float2* pw = c.ws<float2>(WS_PW); const float* kc = c.ws<float>(WS_KC);
#pragma unroll 4
    for (int qq = 0; qq < 8; ++qq) {
        const int i2 = chunk * 4096 + qq * 512 + c.tid;
        float v2[2];
#pragma unroll
        for (int q = 0; q < 2; ++q) {
            const int idx = 2 * i2 + q, k = idx & 511, n = (idx >> 9) & 255, g = idx >> 17, i = n >> 4, hh = n & 15;
            float v;
            if (k < 256) {
                const int d = k >> 7, ri = (k >> 6) & 1, p = k & 63, dg = d * 32 + g, e = d ? 16 - i : i + 1;
                const float2 a = pw[(size_t)(dg * 64 + p) * 20 + e];
                const float cr = c.in(I_CRE)[(size_t)(dg * 16 + hh) * 64 + p], ci = c.in(I_CIM)[(size_t)(dg * 16 + hh) * 64 + p];
                v = ri ? -(cr * a.y + ci * a.x) : (cr * a.x - ci * a.y);
            } else {
                const int j = (k - 256) >> 4, hp = (k - 256) & 15;
                const float k0 = kc[(size_t)((0 * 32 + g) * 16 + (j <= i ? i - j : 0)) * 256 + hh * 16 + hp];
                const float k1 = kc[(size_t)((1 * 32 + g) * 16 + (j >= i ? j - i : 0)) * 256 + hh * 16 + hp];
                v = (j <= i ? k0 : 0.f) + (j >= i ? k1 : 0.f);
                if (j == i && hp == hh) v += c.in(I_SSMD)[g * 16 + hh];
            }
            v2[q] = v;
        }
        c.ws<unsigned>(WS_W3)[i2] = pk2(v2[0], v2[1]);
    }
}

constexpr int CONV_TILES = 32 * 192, CONV_ITEMS = CONV_TILES / 4;
DI void conv_tile(const Ctx& c, int it) {
    constexpr int PER_GU = 16 * 4, PER_D = 4 * 16;
    const int e = it / (2 * PER_GU + PER_D); int r = it % (2 * PER_GU + PER_D);
    if (r < PER_GU) { const int kb = r >> 2, jb = r & 3; tr_tile(c, c.in(I_WEG) + (size_t)e * 1024 * 256, 256, kb * 64, jb * 64, c.ws<bf16_t>(WS_WGU) + (size_t)e * 512 * 1024, 1024, 2, nullptr); return; }
    r -= PER_GU;
    if (r < PER_GU) { const int kb = r >> 2, jb = r & 3; tr_tile(c, c.in(I_WEU) + (size_t)e * 1024 * 256, 256, kb * 64, jb * 64, c.ws<bf16_t>(WS_WGU) + (size_t)e * 512 * 1024, 1024, 3, nullptr); return; }
    r -= PER_GU;
    { const int kb = r >> 4, jb = r & 15; tr_tile(c, c.in(I_WED) + (size_t)e * 256 * 1024, 1024, kb * 64, jb * 64, c.ws<bf16_t>(WS_WD) + (size_t)e * 1024 * 256, 256, 0, nullptr); }
}
DI void bg_run(const Ctx& c, int phase) {
    unsigned* ctl = c.ws<unsigned>(WS_CTL);
    volatile LAS unsigned* slot = (volatile LAS unsigned*)(c.lds + LDS_MISC) + 8;
    __syncthreads();
    if (phase >= 0 && c.tid == 0) xb_add(&ctl[CW_BGDONE + 64 * phase], 1u);
    for (;;) {
        __syncthreads();
        if (c.tid == 0) {
            unsigned item = 0xffffffffu;
            if (phase < 0 || xb_ld(&ctl[CW_BGDONE + 64 * phase]) < (unsigned)c.G) item = xb_add(&ctl[CW_BGHEAD], 1u);
            *slot = item;
        }
        __syncthreads();
        const unsigned item = *slot;
        if (item >= (unsigned)CONV_ITEMS) break;
#pragma unroll 1
        for (int q = 0; q < 4; ++q) conv_tile(c, (int)item * 4 + q);
    }
}
DI void bg_drain(const Ctx& c) { bg_run(c, -1); }

struct EpiStoreBf16 {
    static constexpr int STAGED = 1;
    bf16_t* O; int ld, nrows; float* ssq; bf16_t* U2;
    DI void chunk(int m, int n, const f32x4& v, int) const {
        if (m < nrows) { u32x2 o; o.x = pk2(v.x, v.y); o.y = pk2(v.z, v.w);
            if (U2 != nullptr && n >= 512) {
                int u, j; if (m < MLAT) { const int t = m & 4095; u = (m >> 12) * NUNIT_B + 16 + (t >> 4); j = t & 15; } else { const int tt = (m - MLAT) & 255; u = ((m - MLAT) >> 8) * NUNIT_B + (tt >> 4); j = tt & 15; }
                const int g = (n - 512) >> 4, ch = (n - 512) & 15;
                *(u32x2*)(U2 + (((size_t)u * 32 + g) * 16 + j) * 16 + ch) = o;
            } else *(u32x2*)(O + (size_t)m * ld + n) = o; }
        if (ssq != nullptr && n < 384) {
            float sq = (v.x * v.x + v.y * v.y) + (v.z * v.z + v.w * v.w);
            sq += dpp_f<0xB1>(sq); sq += dpp_f<0x4E>(sq); sq += dpp_f<0x141>(sq); sq += dpp_f<0x140>(sq);
            if ((n & 63) == 0 && m < nrows) ssq[(size_t)m * 8 + (n >> 6)] = sq;
        }
    }
};
template <int PROBE> DI void inproj_tile(const Ctx& c, int mt, int nt) {
    RowLoader<4> al; al.base = c.ws<bf16_t>(WS_XM); al.ld = 1024; al.nrows = MALL;
    RowLoader<2> wl; wl.base = c.ws<bf16_t>(WS_WTIN); wl.ld = 1024; wl.nrows = 1024;
    EpiStoreBf16 epi{c.ws<bf16_t>(WS_P), 512, MALL, c.ws<float>(WS_SSQP), c.ws<bf16_t>(WS_U2)};
    gemm_tile<PROBE>(c, al, wl, mt * 256, nt * 128, 1024, epi, nullptr, -1);
}
template <int PROBE = 0> DI void stage_inproj(const Ctx& c) {
    const int ntile = 68 * 8;
    for (int it = c.vb; it < ntile; it += c.G) inproj_tile<PROBE>(c, it >> 3, it & 7);
    if (PROBE == 0) {
        const int nfree = c.G - (ntile % c.G), first = ntile % c.G;
        if (nfree >= c.G || ntile % c.G == 0) { for (int ch = c.vb; ch < 512; ch += c.G) w3_chunk(c, ch); }
        else if (c.vb >= first) { for (int ch = c.vb - first; ch < 512; ch += nfree) w3_chunk(c, ch); }
    }
}

struct EpiQ {
    static constexpr int STAGED = 2;
    bf16_t* Q; const LAS float* rs; const float* ropec; const float* ropes;
    DI void staged(const LAS float* reg, int lane, int mw, int nw, int lrow0) const {
        const int rr = lane >> 4, cc = (lane & 15) * 4;
        const int n = nw + cc, head = n / 96, d = n % 96;
#pragma unroll 4
        for (int j = 0; j < 16; ++j) {
            const int row = 4 * j + rr, m = mw + row, b = m >> 12, t = m & 4095; const float rq = rs[lrow0 + row] * QSCALE;
            const f32x4 v = *(const LAS f32x4*)(reg + row * 68 + cc);
            bf16_t* q = Q + ((size_t)(b * NH + head) * SEQ + t) * 96 + d;
            f32x4 o;
            if (d < 64) o = v * rq;
            else { const int i = (d - 64) & 15; const bool lo = d < 80;
                const f32x4 pv = *(const LAS f32x4*)(reg + row * 68 + (lo ? cc + 16 : cc - 16));
                const f32x4 cs = *(const f32x4*)(ropec + t * 16 + i), sn = *(const f32x4*)(ropes + t * 16 + i);
                o = lo ? (v * cs - pv * sn) * rq : (v * cs + pv * sn) * rq; }
            u32x2 w; w.x = pk2(o.x, o.y); w.y = pk2(o.z, o.w); *(u32x2*)q = w;
        }
    }
};
struct EpiKV {
    static constexpr int STAGED = 1;
    unsigned char* wsb; const LAS float* rs;
    DI void chunk(int m, int n, const f32x4& v, int lrow) const {
        if (m >= MALL) return;
        int b, key; if (m < MLAT) { b = m >> 12; key = m & 4095; } else { b = (m - MLAT) >> 8; key = SEQ + ((m - MLAT) & 255); }
        const float rk = rs[lrow]; const int head = n >> 7, db = n & 127;
        bf16_t* dst = (bf16_t*)(wsb + (db < 64 ? WS_K : WS_VT)) + ((size_t)(b * NH + head) * NKEY + key) * 64 + (db & 63);
        u32x2 o; o.x = pk2(v.x * rk, v.y * rk); o.y = pk2(v.z * rk, v.w * rk); *(u32x2*)dst = o;
    }
};
struct UcLoader {
    const bf16_t* U2; int g; const bf16_t* rp[4];
    DI void init(int i, int u) { rp[i] = U2 + ((size_t)(u < NUNIT ? u : NUNIT - 1) * 32 + g) * 256; }
    DI const bf16_t* ptr(int i, int k) const { return rp[i] + k; }
};
struct EpiST {
    static constexpr int STAGED = 0;
    bf16_t* ST; int g;
    DI void run(const f32x16 (&acc)[2][2], int mbase, int nb0, int h, int) const {
#pragma unroll
        for (int im = 0; im < 2; ++im) { const int u = mbase + im * 32; if (u >= NUNIT) continue;
#pragma unroll
            for (int in = 0; in < 2; ++in)
#pragma unroll
                for (int gq = 0; gq < 4; ++gq) { const int n = nb0 + in * 32 + 8 * gq + 4 * h; const f32x16& v = acc[in][im];
                    u32x2 o; o.x = pk2(v[4 * gq], v[4 * gq + 1]); o.y = pk2(v[4 * gq + 2], v[4 * gq + 3]); *(u32x2*)(ST + ((size_t)u * 32 + g) * 256 + n) = o; } }
    }
};
template <int MASK = 7> DI void stage_upproj(const Ctx& c) {
    constexpr int N_Q = 64 * 6, N_KV = 68 * 8, N_S1 = 32 * 5 * 2;
    LAS float* rs = (LAS float*)(c.lds + G_SCR);
    const bf16_t* P = c.ws<bf16_t>(WS_P);
    for (int it0 = c.vb; it0 < N_Q + N_KV + N_S1; it0 += c.G) {
        int it = it0;
        __syncthreads();
        if (it < N_Q) {
            if (!(MASK & 1)) continue;
            const int mt = it / 6, nt = it % 6;
            if (c.tid < 256) { const f32x4 s4 = *(const f32x4*)(c.ws<float>(WS_SSQP) + (size_t)(mt * 256 + c.tid) * 8); rs[c.tid] = rsqrtf(((s4.x + s4.y) + (s4.z + s4.w)) * (1.f / 256.f) + EPS); }
            __syncthreads();
            RowLoader<4> al; al.base = P; al.ld = 512; al.nrows = MLAT;
            RowLoader<2> wl; wl.base = c.ws<bf16_t>(WS_WTUQ); wl.ld = 256; wl.nrows = 768;
            EpiQ epi{c.ws<bf16_t>(WS_Q), rs, c.ws<float>(WS_ROPEC), c.ws<float>(WS_ROPES)};
            gemm_tile<(MASK & 8) ? 4 : 0>(c, al, wl, mt * 256, nt * 128, 256, epi, nullptr, -1);
            continue;
        }
        it -= N_Q;
        if (it < N_KV) {
            if (!(MASK & 2)) continue;
            const int mt = it / 8, nt = it % 8;
            if (c.tid < 256) { const f32x2 s2 = *(const f32x2*)(c.ws<float>(WS_SSQP) + (size_t)(mt * 256 + c.tid) * 8 + 4); rs[c.tid] = rsqrtf((s2.x + s2.y) * (1.f / 128.f) + EPS); }
            if (nt == 0) {
                bf16_t* KR = c.ws<bf16_t>(WS_KR);
                for (int idx = c.tid; idx < 256 * 16; idx += NT) {
                    const int row = idx >> 4, i = idx & 15, m = mt * 256 + row;
                    const float t1 = bf2f(P[(size_t)m * 512 + 384 + i]), t2 = bf2f(P[(size_t)m * 512 + 400 + i]);
                    float o1 = t1, o2 = t2; int b, key;
                    if (m < MLAT) { b = m >> 12; key = m & 4095; const float cs = c.ws<float>(WS_ROPEC)[key * 16 + i], sn = c.ws<float>(WS_ROPES)[key * 16 + i]; o1 = t1 * cs - t2 * sn; o2 = t2 * cs + t1 * sn; }
                    else { b = (m - MLAT) >> 8; key = SEQ + ((m - MLAT) & 255); }
                    bf16_t* kp = KR + ((size_t)b * NKEY + key) * 32; kp[i] = f2bf(o1); kp[16 + i] = f2bf(o2);
                }
            }
            __syncthreads();
            RowLoader<4> al; al.base = P + 256; al.ld = 512; al.nrows = MALL;
            RowLoader<2> wl; wl.base = c.ws<bf16_t>(WS_WTUKV); wl.ld = 128; wl.nrows = 1024;
            EpiKV epi{c.p.ws, rs};
            gemm_tile<(MASK & 8) ? 4 : 0>(c, al, wl, mt * 256, nt * 128, 128, epi, nullptr, -1);
            continue;
        }
        it -= N_KV;
        if (MASK & 4) {
            const int g = it / 10, mt = (it % 10) >> 1, nt = it & 1;
            UcLoader al; al.U2 = c.ws<bf16_t>(WS_U2); al.g = g;
            RowLoader<2> wl; wl.base = c.ws<bf16_t>(WS_M16) + (size_t)g * 256 * 256; wl.ld = 256; wl.nrows = 256;
            EpiST epi{c.ws<bf16_t>(WS_ST), g};
            gemm_tile(c, al, wl, mt * 256, nt * 128, 256, epi, nullptr, -1);
        }
    }
}

DI void stage_carry(const Ctx& c) {
    LAS f32x2* segend = (LAS f32x2*)c.lds;
    const int p = c.tid & 63, seg = c.wid;
    for (int it = c.bid; it < NB * 32 * 2; it += c.G) {
        const int d = it & 1, g = (it >> 1) & 31, b = it >> 6;
        const float2 a16 = c.ws<float2>(WS_PW)[(size_t)((d * 32 + g) * 64 + p) * 20 + 16];
        bf16_t* st = c.ws<bf16_t>(WS_ST) + ((size_t)(b * NUNIT_B) * 32 + g) * 256 + d * 128 + p;
        float vr[34], vi[34];
#pragma unroll
        for (int q = 0; q < 34; ++q) { const int s = seg * 34 + q; const int ci = d == 0 ? s : (s < 16 ? 15 - s : (NUNIT_B - 1) - (s - 16)); vr[q] = bf2f(st[(size_t)ci * 8192]); vi[q] = bf2f(st[(size_t)ci * 8192 + 64]); }
        float er = 0.f, ei = 0.f;
#pragma unroll
        for (int q = 0; q < 34; ++q) { const float xr = vr[q], xi = vi[q]; vr[q] = er; vi[q] = ei; const float nr = a16.x * er - a16.y * ei + xr, ni = a16.x * ei + a16.y * er + xi; er = nr; ei = ni; }
        __syncthreads();
        segend[seg * 64 + p] = (f32x2){er, ei};
        float2 a2 = make_float2(a16.x * a16.x - a16.y * a16.y, 2.f * a16.x * a16.y), t = a2;
#pragma unroll
        for (int i = 0; i < 4; ++i) t = make_float2(t.x * t.x - t.y * t.y, 2.f * t.x * t.y);
        const float2 a34 = make_float2(t.x * a2.x - t.y * a2.y, t.x * a2.y + t.y * a2.x);
        __syncthreads();
        float cr = 0.f, ci_ = 0.f;
        for (int j = 0; j < seg; ++j) { const f32x2 e = segend[j * 64 + p]; const float nr = a34.x * cr - a34.y * ci_ + e.x, ni = a34.x * ci_ + a34.y * cr + e.y; cr = nr; ci_ = ni; }
#pragma unroll
        for (int q = 0; q < 34; ++q) { const int s = seg * 34 + q; const int ci = d == 0 ? s : (s < 16 ? 15 - s : (NUNIT_B - 1) - (s - 16));
            st[(size_t)ci * 8192] = f2bf(vr[q] + cr); st[(size_t)ci * 8192 + 64] = f2bf(vi[q] + ci_);
            const float nr = a16.x * cr - a16.y * ci_, ni = a16.x * ci_ + a16.y * cr; cr = nr; ci_ = ni; }
    }
}

struct SsmALoader {
    const bf16_t* U2; const bf16_t* ST; int g; const bf16_t* sp[4]; const bf16_t* up[4];
    DI void init(int i, int u) { const int uu = u < NUNIT ? u : NUNIT - 1; sp[i] = ST + ((size_t)uu * 32 + g) * 256; up[i] = U2 + ((size_t)uu * 32 + g) * 256; }
    DI const bf16_t* ptr(int i, int k) const { return k < 256 ? sp[i] + k : up[i] + (k - 256); }
};
struct EpiG {
    static constexpr int STAGED = 0;
    bf16_t* Gb; int g;
    DI void run(const f32x16 (&acc)[2][2], int mbase, int nb0, int h, int) const {
#pragma unroll
        for (int im = 0; im < 2; ++im) { const int u = mbase + im * 32; if (u >= NUNIT) continue; const int b = u / NUNIT_B, cc = u % NUNIT_B; if (cc < 16) continue;
            const int row0 = b * SEQ + 16 * (cc - 16);
#pragma unroll
            for (int in = 0; in < 2; ++in)
#pragma unroll
                for (int gq = 0; gq < 4; ++gq) { const int n = nb0 + in * 32 + 8 * gq + 4 * h, i = n >> 4, hh = n & 15; const f32x16& v = acc[in][im];
                    u32x2 o; o.x = pk2(geluf_(v[4 * gq]), geluf_(v[4 * gq + 1])); o.y = pk2(geluf_(v[4 * gq + 2]), geluf_(v[4 * gq + 3]));
                    *(u32x2*)(Gb + (size_t)(row0 + i) * 512 + 16 * g + hh) = o; } }
    }
};
DI void stage_ssmout(const Ctx& c) {
    for (int it = c.vb; it < 320; it += c.G) {
        const int g = it / 10, mt = (it % 10) >> 1, nt = it & 1;
        SsmALoader al; al.U2 = c.ws<bf16_t>(WS_U2); al.ST = c.ws<bf16_t>(WS_ST); al.g = g;
        RowLoader<2> wl; wl.base = c.ws<bf16_t>(WS_W3) + (size_t)g * 256 * 512; wl.ld = 512; wl.nrows = 256;
        EpiG epi{c.ws<bf16_t>(WS_G), g};
        gemm_tile(c, al, wl, mt * 256, nt * 128, 512, epi, nullptr, -1);
    }
}

struct EpiGLU {
    static constexpr int STAGED = 0;
    const bf16_t* Gb; bf16_t* Mix; const float* bias; float* ssq;
    DI void run(const f32x16 (&acc)[2][2], int mbase, int nb0, int h, int) const {
#pragma unroll
        for (int im = 0; im < 2; ++im) { const int m = mbase + im * 32; float sq = 0.f;
#pragma unroll
            for (int in = 0; in < 2; ++in)
#pragma unroll
                for (int g = 0; g < 4; ++g) { const int n = nb0 + in * 32 + 8 * g + 4 * h; const f32x16& v = acc[in][im];
                    const u32x2 gg = *(const u32x2*)(Gb + (size_t)m * 512 + n); const f32x4 bb = *(const f32x4*)(bias + n);
                    const float g0 = lo16(gg.x), g1 = hi16(gg.x), g2 = lo16(gg.y), g3 = hi16(gg.y);
                    const float o0 = g0 * sigmoidf_(v[4 * g] + bb.x), o1 = g1 * sigmoidf_(v[4 * g + 1] + bb.y), o2 = g2 * sigmoidf_(v[4 * g + 2] + bb.z), o3 = g3 * sigmoidf_(v[4 * g + 3] + bb.w);
                    sq += (o0 * o0 + o1 * o1) + (o2 * o2 + o3 * o3);
                    u32x2 o; o.x = pk2(o0, o1); o.y = pk2(o2, o3);
                    *(u32x2*)(Mix + (size_t)m * 1024 + 512 + n) = o; }
            sq += __shfl_xor(sq, 32);
            if (h == 0) ssq[(size_t)m * 8 + (nb0 >> 6)] = sq; }
    }
};
DI void stage_glu(const Ctx& c) {
    for (int it = c.vb; it < 64 * 4; it += c.G) {
        const int mt = it >> 2, nt = it & 3;
        RowLoader<4> al; al.base = c.ws<bf16_t>(WS_G); al.ld = 512; al.nrows = MLAT;
        RowLoader<2> wl; wl.base = c.ws<bf16_t>(WS_WTGLU); wl.ld = 512; wl.nrows = 512;
        EpiGLU epi{c.ws<bf16_t>(WS_G), c.ws<bf16_t>(WS_MIX), c.in(I_BGLU), c.ws<float>(WS_SSQS)};
        gemm_tile(c, al, wl, mt * 256, nt * 128, 512, epi, nullptr, -1);
    }
    bg_drain(c);
}

constexpr int AT_KROW = 208, AT_VROW = 192, AT_KBYTES = 64 * AT_KROW, AT_VBYTES = 64 * AT_VROW, AT_VOFF = 3 * AT_KBYTES;
constexpr float AT_THR = 8.f;
typedef short s16x4 __attribute__((ext_vector_type(4)));
DI bf16x8 tr_frag(const LAS unsigned char* p) {
    const s16x4 lo = __builtin_amdgcn_ds_read_tr16_b64_v4i16((LAS s16x4*)p), hi = __builtin_amdgcn_ds_read_tr16_b64_v4i16((LAS s16x4*)(p + 8 * AT_VROW));
    return __builtin_shufflevector(lo, hi, 0, 1, 2, 3, 4, 5, 6, 7);
}
DI void stage_attn(const Ctx& c, int ufirst, int ulast) {
    const int lane = c.lane, wid = c.wid, r = lane & 31, h = lane >> 5, tid = c.tid;
    const bf16_t* Qb = c.ws<bf16_t>(WS_Q); const bf16_t* Kb = c.ws<bf16_t>(WS_K); const bf16_t* Vt = c.ws<bf16_t>(WS_VT);
    bf16_t* Mix = c.ws<bf16_t>(WS_MIX);
    constexpr int NTILE = NKEY / 64;
    for (int unit = ufirst + c.vb; unit < ulast; unit += c.G) {
        const int qb = unit & 15, bh = unit >> 4, b = bh >> 3, hd = bh & 7;
        const int q0 = qb * 256 + wid * 32;
        bf16x8 qf[6];
        { const bf16_t* qp = Qb + ((size_t)bh * SEQ + q0 + r) * 96 + 8 * h;
#pragma unroll
          for (int ks = 0; ks < 6; ++ks) qf[ks] = *(const bf16x8*)(qp + ks * 16); }
        const int kq0 = tid, kq1 = tid + 512, vr = tid >> 3, vc = tid & 7;
        const int klo0 = (kq0 / 12) * AT_KROW + (kq0 % 12) * 16, klo1 = (kq1 / 12) * AT_KROW + (kq1 % 12) * 16, vlo = vr * AT_VROW + vc * 16;
        const unsigned char* wsb = c.p.ws;
        const int kc0 = kq0 % 12, kc1 = kq1 % 12;
        const unsigned knb = (unsigned)WS_K + (unsigned)bh * NKEY * 128u, krb = (unsigned)WS_KR + (unsigned)b * NKEY * 64u;
        unsigned ko0 = kc0 < 8 ? knb + (kq0 / 12) * 128u + kc0 * 16u : krb + (kq0 / 12) * 64u + (kc0 - 8) * 16u; const unsigned kst0 = kc0 < 8 ? 64u * 128u : 64u * 64u;
        unsigned ko1 = kc1 < 8 ? knb + (kq1 / 12) * 128u + kc1 * 16u : krb + (kq1 / 12) * 64u + (kc1 - 8) * 16u; const unsigned kst1 = kc1 < 8 ? 64u * 128u : 64u * 64u;
        unsigned vo = (unsigned)WS_VT + (unsigned)bh * NKEY * 128u + (unsigned)tid * 16u;
        u32x4 rk0, rk1 = (u32x4){0u, 0u, 0u, 0u}, rv;
        f32x16 o[2]; float mrun = 0.f, lrun = 0.f;
#pragma unroll
        for (int i = 0; i < 2; ++i)
#pragma unroll
            for (int e = 0; e < 16; ++e) o[i][e] = 0.f;
        __syncthreads();
        rk0 = *(const u32x4*)(wsb + ko0); if (tid < 256) rk1 = *(const u32x4*)(wsb + ko1);
        rv = *(const u32x4*)(wsb + vo);
        *(LAS u32x4*)(c.lds + klo0) = rk0; if (tid < 256) *(LAS u32x4*)(c.lds + klo1) = rk1;
        *(LAS u32x4*)(c.lds + AT_VOFF + vlo) = rv;
        ko0 += kst0; ko1 += kst1; vo += 8192u;
        rk0 = *(const u32x4*)(wsb + ko0); if (tid < 256) rk1 = *(const u32x4*)(wsb + ko1);
        *(LAS u32x4*)(c.lds + AT_KBYTES + klo0) = rk0; if (tid < 256) *(LAS u32x4*)(c.lds + AT_KBYTES + klo1) = rk1;
        ko0 += kst0; ko1 += kst1;
        __syncthreads();
        f32x16 sa[2], sb[2];
        {
            const LAS unsigned char* sk = c.lds + r * AT_KROW + h * 16;
#pragma unroll
            for (int kt2 = 0; kt2 < 2; ++kt2) {
#pragma unroll
                for (int e = 0; e < 16; ++e) sa[kt2][e] = 0.f;
#pragma unroll
                for (int ks = 0; ks < 6; ++ks) { const bf16x8 kf = *(const LAS bf16x8*)(sk + kt2 * 32 * AT_KROW + ks * 32); sa[kt2] = MFMA32(kf, qf[ks], sa[kt2]); }
            }
        }
        int ks1 = 1, ks2 = 2, vs0 = 0;
#define ATT_STEP(SA, SB, T)                                                                                                        \
        {                                                                                                                           \
            const int t_ = (T);                                                                                                     \
            if (t_ + 2 < NTILE) { rk0 = *(const u32x4*)(wsb + ko0); if (tid < 256) rk1 = *(const u32x4*)(wsb + ko1); ko0 += kst0; ko1 += kst1; }   \
            if (t_ + 1 < NTILE) { rv = *(const u32x4*)(wsb + vo); vo += 8192u; }                                                  \
            float mx = SA[0][0];                                                                                                    \
            _Pragma("unroll") for (int e = 1; e < 16; ++e) mx = fmaxf(mx, SA[0][e]);                                               \
            _Pragma("unroll") for (int e = 0; e < 16; ++e) mx = fmaxf(mx, SA[1][e]);                                               \
            mx = fmaxf(mx, __shfl_xor(mx, 32));                                                                                     \
            if (t_ == 0 || __any(mx > AT_THR)) {                                                                                    \
                const float delta = t_ == 0 ? mx : fmaxf(mx, 0.f), alpha = __builtin_amdgcn_exp2f(-delta);                          \
                mrun += delta; lrun *= alpha;                                                                                       \
                _Pragma("unroll") for (int e = 0; e < 16; ++e) { o[0][e] *= alpha; o[1][e] *= alpha; SA[0][e] -= delta; SA[1][e] -= delta; } \
            }                                                                                                                       \
            __builtin_amdgcn_s_setprio(1);                                                                                          \
            if (t_ + 1 < NTILE) {                                                                                                   \
                const LAS unsigned char* sk = c.lds + ks1 * AT_KBYTES + r * AT_KROW + h * 16; const float nm = -mrun;               \
                _Pragma("unroll") for (int kt2 = 0; kt2 < 2; ++kt2) {                                                               \
                    _Pragma("unroll") for (int e = 0; e < 16; ++e) SB[kt2][e] = nm;                                                 \
                    _Pragma("unroll") for (int ks = 0; ks < 6; ++ks) { const bf16x8 kf = *(const LAS bf16x8*)(sk + kt2 * 32 * AT_KROW + ks * 32); SB[kt2] = MFMA32(kf, qf[ks], SB[kt2]); } \
                }                                                                                                                   \
            }                                                                                                                       \
            float ps = 0.f;                                                                                                         \
            _Pragma("unroll") for (int kt2 = 0; kt2 < 2; ++kt2)                                                                     \
                _Pragma("unroll") for (int e = 0; e < 16; ++e) { const float pv = __builtin_amdgcn_exp2f(SA[kt2][e]); SA[kt2][e] = pv; ps += pv; } \
            lrun += ps;                                                                                                             \
            const LAS unsigned char* sv = c.lds + AT_VOFF + vs0 * AT_VBYTES + (4 * h + ((lane & 15) >> 2)) * AT_VROW + (16 * ((lane >> 4) & 1) + 4 * (lane & 3)) * 2; \
            _Pragma("unroll") for (int kt2 = 0; kt2 < 2; ++kt2)                                                                     \
                _Pragma("unroll") for (int s = 0; s < 2; ++s) {                                                                     \
                    u32x4 pp; pp.x = pk2(SA[kt2][8 * s], SA[kt2][8 * s + 1]); pp.y = pk2(SA[kt2][8 * s + 2], SA[kt2][8 * s + 3]);   \
                    pp.z = pk2(SA[kt2][8 * s + 4], SA[kt2][8 * s + 5]); pp.w = pk2(SA[kt2][8 * s + 6], SA[kt2][8 * s + 7]);         \
                    const bf16x8 pb = __builtin_bit_cast(bf16x8, pp);                                                               \
                    _Pragma("unroll") for (int dt = 0; dt < 2; ++dt) { const bf16x8 vf = tr_frag(sv + (kt2 * 32 + s * 16) * AT_VROW + dt * 64); o[dt] = MFMA32(vf, pb, o[dt]); } \
                }                                                                                                                   \
            __builtin_amdgcn_s_setprio(0);                                                                                          \
            if (t_ + 2 < NTILE) { LAS unsigned char* sb_ = c.lds + ks2 * AT_KBYTES; *(LAS u32x4*)(sb_ + klo0) = rk0; if (tid < 256) *(LAS u32x4*)(sb_ + klo1) = rk1; } \
            if (t_ + 1 < NTILE) *(LAS u32x4*)(c.lds + AT_VOFF + (vs0 ^ 1) * AT_VBYTES + vlo) = rv;                                  \
            __syncthreads();                                                                                                        \
            ks1 = ks1 == 2 ? 0 : ks1 + 1; ks2 = ks2 == 2 ? 0 : ks2 + 1; vs0 ^= 1;                                                   \
        }
        for (int t = 0; t < NTILE; t += 2) {
            ATT_STEP(sa, sb, t)
            ATT_STEP(sb, sa, t + 1)
        }
#undef ATT_STEP
        const float linv = 1.f / (lrun + __shfl_xor(lrun, 32));
        { float sq = 0.f;
#pragma unroll
          for (int dt = 0; dt < 2; ++dt)
#pragma unroll
              for (int e = 0; e < 16; ++e) { const float v = o[dt][e] * linv; sq += v * v; }
          sq += __shfl_xor(sq, 32);
          if (h == 0) c.ws<float>(WS_SSQA)[(size_t)(b * SEQ + q0 + r) * 8 + hd] = sq; }
        bf16_t* op = Mix + (size_t)(b * SEQ + q0 + r) * 1024 + hd * 64;
#pragma unroll
        for (int dt = 0; dt < 2; ++dt)
#pragma unroll
            for (int g = 0; g < 4; ++g) { u32x2 w; w.x = pk2(o[dt][4 * g] * linv, o[dt][4 * g + 1] * linv); w.y = pk2(o[dt][4 * g + 2] * linv, o[dt][4 * g + 3] * linv);
                *(u32x2*)(op + dt * 32 + 8 * g + 4 * h) = w; }
    }
}

struct EpiWo {
    static constexpr int STAGED = 1;
    const float* x; bf16_t* y1; const float* mod; const LAS float* rssm;
    DI void chunk(int m, int n, const f32x4& v, int lrow) const {
        const int b = m >> 12; const float rs = rssm[lrow];
        const f32x4 xv = *(const f32x4*)(x + (size_t)m * 1024 + n), gv = *(const f32x4*)(mod + (size_t)b * 6144 + 2048 + n);
        const f32x4 y = ALPHA * xv + gv * (v * rs);
        u32x2 o; o.x = pk2(y.x, y.y); o.y = pk2(y.z, y.w); *(u32x2*)(y1 + (size_t)m * 1024 + n) = o;
    }
};
DI void stage_wo(const Ctx& c) {
    LAS float* ratio = (LAS float*)(c.lds + G_SCR);
    LAS float* rssm = ratio + 256;
    const bf16_t* Mix = c.ws<bf16_t>(WS_MIX);
    for (int it = c.vb; it < 64 * 4; it += c.G) {
        const int mt = it >> 2, nt = it & 3;
        __syncthreads();
        if (c.tid < 256) { const int row = mt * 256 + c.tid;
          const f32x4 a0 = *(const f32x4*)(c.ws<float>(WS_SSQA) + (size_t)row * 8), a1 = *(const f32x4*)(c.ws<float>(WS_SSQA) + (size_t)row * 8 + 4);
          const f32x4 s0 = *(const f32x4*)(c.ws<float>(WS_SSQS) + (size_t)row * 8), s1 = *(const f32x4*)(c.ws<float>(WS_SSQS) + (size_t)row * 8 + 4);
          const float sa = ((a0.x + a0.y) + (a0.z + a0.w)) + ((a1.x + a1.y) + (a1.z + a1.w)), ss = ((s0.x + s0.y) + (s0.z + s0.w)) + ((s1.x + s1.y) + (s1.z + s1.w));
          const float ra = rsqrtf(sa * (1.f / 512.f) + EPS), rs = rsqrtf(ss * (1.f / 512.f) + EPS);
          ratio[c.tid] = ra / rs; rssm[c.tid] = rs; }
        __syncthreads();
        EpiWo epi{c.in(I_X), c.ws<bf16_t>(WS_Y1B), c.ws<float>(WS_MOD), rssm};
        gemm_tile256(c, Mix, 1024, c.ws<bf16_t>(WS_WTO), 1024, mt * 256, nt * 256, 1024, epi, ratio, 15);
    }
}

DI void stage_ln1(const Ctx& c) {
    const float* mod = c.ws<float>(WS_MOD);
    unsigned* ctl = c.ws<unsigned>(WS_CTL);
    constexpr int HROW = 2064;
    LAS unsigned char* hh = c.lds; LAS unsigned char* hl = c.lds + 32 * HROW;
    LAS float* P = (LAS float*)c.lds;
    LAS float* LG = (LAS float*)(c.lds + 64 * HROW);
    LAS unsigned* lcnt = (LAS unsigned*)(c.lds + 140032);
    LAS unsigned* lbase = lcnt + 32;
    LAS unsigned* dec = lcnt + 64;
    const bf16_t* WrH = c.ws<bf16_t>(WS_WRH); const bf16_t* WrL = c.ws<bf16_t>(WS_WRL);
    const int r = c.lane & 31, h = c.lane >> 5;
    for (int rb = c.bid; rb < MLAT / 64; rb += c.G) {
        __syncthreads();
        if (c.tid < 32) lcnt[c.tid] = 0u;
        for (int half = 0; half < 2; ++half) {
            const int rowb = rb * 64 + half * 32, b = rowb >> 12;
            __syncthreads();
            {
                const int row0 = rowb + c.wid * 4;
                f32x4 lg_[4], lb_[4], sh_[4], sc_[4];
#pragma unroll
                for (int j = 0; j < 4; ++j) { const int n = (c.lane + 64 * j) * 4; lg_[j] = *(const f32x4*)(c.in(I_LN1G) + n); lb_[j] = *(const f32x4*)(c.in(I_LN1B) + n);
                    sh_[j] = *(const f32x4*)(mod + (size_t)b * 6144 + 3072 + n); sc_[j] = *(const f32x4*)(mod + (size_t)b * 6144 + 4096 + n) + 1.f; }
#pragma unroll 1
                for (int rp = 0; rp < 2; ++rp) {
                    f32x4 hv[2][4];
#pragma unroll
                    for (int rr = 0; rr < 2; ++rr)
#pragma unroll
                        for (int j = 0; j < 4; ++j) { const u32x2 yb = *(const u32x2*)(c.ws<bf16_t>(WS_Y1B) + (size_t)(row0 + rp * 2 + rr) * 1024 + (c.lane + 64 * j) * 4); hv[rr][j] = (f32x4){lo16(yb.x), hi16(yb.x), lo16(yb.y), hi16(yb.y)}; }
#pragma unroll
                    for (int rr = 0; rr < 2; ++rr) {
                        const int lr = c.wid * 4 + rp * 2 + rr, row = rowb + lr;
                        float s = 0.f;
#pragma unroll
                        for (int j = 0; j < 4; ++j) s += (hv[rr][j].x + hv[rr][j].y) + (hv[rr][j].z + hv[rr][j].w);
                        const float mean = wave_sum_fast(s) * (1.f / 1024.f); float q = 0.f;
#pragma unroll
                        for (int j = 0; j < 4; ++j) { hv[rr][j] = hv[rr][j] - mean; q += (hv[rr][j].x * hv[rr][j].x + hv[rr][j].y * hv[rr][j].y) + (hv[rr][j].z * hv[rr][j].z + hv[rr][j].w * hv[rr][j].w); }
                        const float rstd = rsqrtf(wave_sum_fast(q) * (1.f / 1024.f) + EPS);
                        if (c.lane == 0) *(f32x2*)(c.ws<float>(WS_STATS) + (size_t)row * 2) = (f32x2){mean, rstd};
#pragma unroll
                        for (int j = 0; j < 4; ++j) { const int n = (c.lane + 64 * j) * 4;
                            const f32x4 hq = (hv[rr][j] * rstd * lg_[j] + lb_[j]) * sc_[j] + sh_[j];
                            u32x2 o; o.x = pk2(hq.x, hq.y); o.y = pk2(hq.z, hq.w); *(u32x2*)(c.ws<bf16_t>(WS_H) + (size_t)row * 1024 + n) = o;
                            u32x2 l; l.x = pk2(hq.x - lo16(o.x), hq.y - hi16(o.x)); l.y = pk2(hq.z - lo16(o.y), hq.w - hi16(o.y));
                            *(LAS u32x2*)(hh + lr * HROW + n * 2) = o; *(LAS u32x2*)(hl + lr * HROW + n * 2) = l; }
                    }
                }
            }
            __syncthreads();
            f32x16 acc[2];
#pragma unroll
            for (int et = 0; et < 2; ++et)
#pragma unroll
                for (int e = 0; e < 16; ++e) acc[et][e] = 0.f;
#pragma unroll
            for (int ks = 0; ks < 8; ++ks) {
                const int k0 = c.wid * 128 + ks * 16 + 8 * h;
                const bf16x8 bh = *(const LAS bf16x8*)(hh + r * HROW + k0 * 2), bl = *(const LAS bf16x8*)(hl + r * HROW + k0 * 2);
#pragma unroll
                for (int et = 0; et < 2; ++et) {
                    const bf16x8 wh = *(const bf16x8*)(WrH + (size_t)(et * 32 + r) * 1024 + k0), wl = *(const bf16x8*)(WrL + (size_t)(et * 32 + r) * 1024 + k0);
                    acc[et] = MFMA32(wh, bh, acc[et]); acc[et] = MFMA32(wh, bl, acc[et]); acc[et] = MFMA32(wl, bh, acc[et]);
                }
            }
            __syncthreads();
#pragma unroll
            for (int et = 0; et < 2; ++et)
#pragma unroll
                for (int g = 0; g < 4; ++g) *(LAS f32x4*)(P + (c.wid * 32 + r) * 64 + et * 32 + 8 * g + 4 * h) = (f32x4){acc[et][4 * g], acc[et][4 * g + 1], acc[et][4 * g + 2], acc[et][4 * g + 3]};
            __syncthreads();
            {
                const int m = c.tid & 31, e0 = c.tid >> 5;
#pragma unroll
                for (int q = 0; q < 3; ++q) { const int e = e0 + 16 * q; if (e < 36) { float s = e < 4 ? c.in(I_BRG)[e] : c.in(I_BRE2)[e - 4];
#pragma unroll
                    for (int w = 0; w < 8; ++w) s += P[(w * 32 + m) * 64 + e];
                    LG[m * 40 + e] = s; } }
            }
            __syncthreads();
            if (c.tid < 32) {
                const LAS float* l = LG + c.tid * 40; const int row = rowb + c.tid;
                int gi = 0; float gm = l[0];
#pragma unroll
                for (int e = 1; e < 4; ++e) if (l[e] > gm) { gm = l[e]; gi = e; }
                float gs = 0.f;
#pragma unroll
                for (int e = 0; e < 4; ++e) gs += __expf(l[e] - gm);
                const float gw = 1.f / gs;
                float el[8];
#pragma unroll
                for (int j = 0; j < 8; ++j) el[j] = l[4 + gi * 8 + j];
                int i1 = 0; float l1 = el[0];
#pragma unroll
                for (int j = 1; j < 8; ++j) if (el[j] > l1) { l1 = el[j]; i1 = j; }
                int i2 = -1; float l2 = -3.0e38f;
#pragma unroll
                for (int j = 0; j < 8; ++j) if (j != i1 && el[j] > l2) { l2 = el[j]; i2 = j; }
                const float ex = __expf(l2 - l1), w1 = gw / (1.f + ex), w2 = gw * ex / (1.f + ex);
                const int e1 = gi * 8 + i1, e2 = gi * 8 + i2;
                const int slot = half * 32 + c.tid;
                const unsigned r1 = atomicAdd((unsigned*)&lcnt[e1], 1u), r2 = atomicAdd((unsigned*)&lcnt[e2], 1u);
                dec[slot * 4 + 0] = (unsigned)e1 | (r1 << 8); dec[slot * 4 + 1] = (unsigned)e2 | (r2 << 8); dec[slot * 4 + 2] = (unsigned)row;
                float* tw = c.ws<float>(WS_TOKW); tw[row * 2] = w1; tw[row * 2 + 1] = w2;
            }
        }
        __syncthreads();
        if (c.tid < 32) { const unsigned n = lcnt[c.tid]; lbase[c.tid] = n ? atomicAdd(&ctl[CNT_IDX(c.tid)], n) : 0u; }
        __syncthreads();
        if (c.tid < 64) {
            const unsigned d0 = dec[c.tid * 4], d1 = dec[c.tid * 4 + 1], row = dec[c.tid * 4 + 2];
            int* list = c.ws<int>(WS_LIST);
            list[(d0 & 255u) * 16384 + lbase[d0 & 255u] + (d0 >> 8)] = (int)(row * 2);
            list[(d1 & 255u) * 16384 + lbase[d1 & 255u] + (d1 >> 8)] = (int)(row * 2 + 1);
        }
    }
}

struct GatherLoader {
    const bf16_t* src; const int* list; int cnt, ld, shift; const bf16_t* rp[4];
    DI void init(int i, int m) { const int ts = list[m < cnt ? m : cnt - 1]; rp[i] = src + (size_t)(ts >> shift) * ld; }
    DI const bf16_t* ptr(int i, int k) const { return rp[i] + k; }
};
struct EpiZ {
    static constexpr int STAGED = 0;
    bf16_t* Z; const int* list; const float* tw; int cnt, m00;
    DI void run(const f32x16 (&acc)[2][2], int mbase, int nb0, int h, int) const {
#pragma unroll
        for (int im = 0; im < 2; ++im) { const int ml = mbase + im * 32 - m00; if (ml >= cnt) continue; const int ts = list[ml]; const float w = tw[ts];
            const int jb = (nb0 >> 6) * 32;
#pragma unroll
            for (int g = 0; g < 4; ++g) { const f32x16& a = acc[0][im]; const f32x16& u = acc[1][im];
                u32x2 o; o.x = pk2(siluf_(a[4 * g]) * u[4 * g] * w, siluf_(a[4 * g + 1]) * u[4 * g + 1] * w); o.y = pk2(siluf_(a[4 * g + 2]) * u[4 * g + 2] * w, siluf_(a[4 * g + 3]) * u[4 * g + 3] * w);
                *(u32x2*)(Z + (size_t)ts * 256 + jb + 8 * g + 4 * h) = o; } }
    }
};
struct EpiF {
    static constexpr int STAGED = 1;
    bf16_t* F; const int* list; int cnt, m00;
    DI void chunk(int m, int n, const f32x4& v, int) const {
        const int ml = m - m00; if (ml < cnt) { const int ts = list[ml]; u32x2 o; o.x = pk2(v.x, v.y); o.y = pk2(v.z, v.w); *(u32x2*)(F + (size_t)ts * 1024 + n) = o; }
    }
};
template <int DOWN> DI void stage_expert(const Ctx& c) {
    unsigned* ctl = c.ws<unsigned>(WS_CTL);
    constexpr int NNT = DOWN ? 8 : 4;
    LAS int* lcnt = (LAS int*)(c.lds + G_SCR);
    LAS int* lpre = lcnt + 32;
    __syncthreads();
    if (c.tid < 32) lcnt[c.tid] = (int)xb_ld(&ctl[CNT_IDX(c.tid)]);
    __syncthreads();
    if (c.tid == 0) { int a = 0; for (int e = 0; e < 32; ++e) { lpre[e] = a; a += ((lcnt[e] + 255) >> 8) * NNT; } lpre[32] = a; }
    __syncthreads();
    const int tot = lpre[32];
    for (int it = c.vb; it < tot; it += c.G) {
        int e = 0;
#pragma unroll
        for (int s = 16; s >= 1; s >>= 1) if (lpre[e + s] <= it) e += s;
        const int acc0 = lpre[e], cnt = lcnt[e];
        const int r = it - acc0, mt = r / NNT, nt = r % NNT;
        const int* list = c.ws<int>(WS_LIST) + e * 16384;
        if (!DOWN) {
            GatherLoader al; al.src = c.ws<bf16_t>(WS_H); al.list = list; al.cnt = cnt; al.ld = 1024; al.shift = 1;
            RowLoader<2> wl; wl.base = c.ws<bf16_t>(WS_WGU) + (size_t)e * 512 * 1024; wl.ld = 1024; wl.nrows = 512;
            EpiZ epi{c.ws<bf16_t>(WS_Z), list, c.ws<float>(WS_TOKW), cnt, 0};
            gemm_tile(c, al, wl, mt * 256, nt * 128, 1024, epi, nullptr, -1);
        } else {
            GatherLoader al; al.src = c.ws<bf16_t>(WS_Z); al.list = list; al.cnt = cnt; al.ld = 256; al.shift = 0;
            RowLoader<2> wl; wl.base = c.ws<bf16_t>(WS_WD) + (size_t)e * 1024 * 256; wl.ld = 256; wl.nrows = 1024;
            EpiF epi{c.ws<bf16_t>(WS_F), list, cnt, 0};
            gemm_tile(c, al, wl, mt * 256, nt * 128, 256, epi, nullptr, -1);
        }
    }
}

DI void stage_final(const Ctx& c) {
    const float* mod = c.ws<float>(WS_MOD); const bf16_t* F = c.ws<bf16_t>(WS_F); const bf16_t* Y = c.ws<bf16_t>(WS_Y1B);
    const int gw = c.bid * 8 + c.wid, nw = c.G * 8;
    for (int row0 = gw; row0 < MLAT; row0 += nw * 4) {
        u32x2 yb[4][4], f0[4][4], f1[4][4]; f32x2 st[4];
#pragma unroll
        for (int q = 0; q < 4; ++q) { const int row = row0 + q * nw; if (row < MLAT) {
            st[q] = *(const f32x2*)(c.ws<float>(WS_STATS) + (size_t)row * 2);
#pragma unroll
            for (int j = 0; j < 4; ++j) { const int n = (c.lane + 64 * j) * 4; yb[q][j] = *(const u32x2*)(Y + (size_t)row * 1024 + n);
                f0[q][j] = *(const u32x2*)(F + (size_t)(row * 2) * 1024 + n); f1[q][j] = *(const u32x2*)(F + (size_t)(row * 2 + 1) * 1024 + n); } } }
#pragma unroll
        for (int q = 0; q < 4; ++q) { const int row = row0 + q * nw; if (row < MLAT) {
            const int b = row >> 12; float* orow = c.p.out + (size_t)row * 1024;
            f32x4 y[4]; float s = 0.f;
#pragma unroll
            for (int j = 0; j < 4; ++j) { const int n = (c.lane + 64 * j) * 4;
                const f32x4 y1 = {lo16(yb[q][j].x), hi16(yb[q][j].x), lo16(yb[q][j].y), hi16(yb[q][j].y)}, gf = *(const f32x4*)(mod + (size_t)b * 6144 + 5120 + n);
                const f32x4 x1 = (y1 - st[q].x) * st[q].y * *(const f32x4*)(c.in(I_LN1G) + n) + *(const f32x4*)(c.in(I_LN1B) + n);
                f32x4 ff; ff.x = lo16(f0[q][j].x) + lo16(f1[q][j].x); ff.y = hi16(f0[q][j].x) + hi16(f1[q][j].x); ff.z = lo16(f0[q][j].y) + lo16(f1[q][j].y); ff.w = hi16(f0[q][j].y) + hi16(f1[q][j].y);
                y[j] = ALPHA * x1 + gf * ff; s += (y[j].x + y[j].y) + (y[j].z + y[j].w); }
            const float mean = wave_sum_fast(s) * (1.f / 1024.f); float qq = 0.f;
#pragma unroll
            for (int j = 0; j < 4; ++j) { y[j] = y[j] - mean; qq += (y[j].x * y[j].x + y[j].y * y[j].y) + (y[j].z * y[j].z + y[j].w * y[j].w); }
            const float rstd = rsqrtf(wave_sum_fast(qq) * (1.f / 1024.f) + EPS);
#pragma unroll
            for (int j = 0; j < 4; ++j) { const int n = (c.lane + 64 * j) * 4;
                const f32x4 g = *(const f32x4*)(c.in(I_LN2G) + n), bb = *(const f32x4*)(c.in(I_LN2B) + n);
                *(f32x4*)(orow + n) = y[j] * rstd * g + bb; } } }
    }
}

__global__ void __launch_bounds__(NT, 2) mega(Params p) {
    extern __shared__ __attribute__((aligned(16))) unsigned char lds_raw[];
    Ctx c; c.p = p; c.lds = (LAS unsigned char*)lds_raw; c.tid = threadIdx.x; c.lane = c.tid & 63; c.wid = __builtin_amdgcn_readfirstlane(c.tid >> 6); c.bid = blockIdx.x; c.G = gridDim.x; c.vb = (c.G % 8 == 0) ? (c.bid % 8) * (c.G / 8) + c.bid / 8 : c.bid;
    volatile LAS unsigned* misc = (volatile LAS unsigned*)(c.lds + LDS_MISC);
    if (c.tid < 16) misc[c.tid] = 0u;
    __syncthreads();
    unsigned* ctl = c.ws<unsigned>(WS_CTL);
    XcdBarrier bar = xcd_barrier_post(ctl + CW_BAR, misc);
#define BAR() xcd_barrier(bar)
    stage_prep(c); BAR();
    stage_s1(c); BAR();
    stage_inproj(c); bg_run(c, 0); BAR();
    stage_upproj(c); bg_run(c, 1); BAR();
    stage_carry(c); stage_attn(c, 0, 256); BAR();
    stage_ssmout(c); stage_attn(c, 256, 512); BAR();
    stage_glu(c); BAR();
    stage_wo(c); BAR();
    stage_ln1(c); BAR();
    stage_expert<0>(c); BAR();
    stage_expert<1>(c); BAR();
    stage_final(c);
}

extern "C" void kernel_launch(void* const* d_in, const int* in_sizes, int n_in, void* d_out, int out_size, void* d_ws, size_t ws_size, hipStream_t stream) {
    static int grid = 0;
    if (grid == 0) {
        int dev = 0, cus = 0, per_cu = 0;
        (void)hipGetDevice(&dev);
        (void)hipDeviceGetAttribute(&cus, hipDeviceAttributeMultiprocessorCount, dev);
        (void)hipFuncSetAttribute((const void*)mega, hipFuncAttributeMaxDynamicSharedMemorySize, LDS_BYTES);
        (void)hipOccupancyMaxActiveBlocksPerMultiprocessor(&per_cu, (const void*)mega, NT, LDS_BYTES);
        (void)hipGetLastError();
        if (per_cu < 1) fprintf(stderr, "kernel_launch: occupancy query reports %d workgroups per CU\n", per_cu);
        if (ws_size < 256 * MiB) fprintf(stderr, "kernel_launch: workspace too small: %zu\n", ws_size);
        grid = cus > 0 ? cus : 256;
    }
    (void)hipMemsetAsync((char*)d_ws + WS_CTL, 0, 64 * 1024, stream);
    Params p{};
    for (int i = 0; i < N_IN && i < n_in; ++i) p.in[i] = (const float*)d_in[i];
    p.out = (float*)d_out; p.ws = (unsigned char*)d_ws;
    hipLaunchKernelGGL(mega, dim3(grid), dim3(NT), LDS_BYTES, stream, p);
}
```

```cpp
#include <hip/hip_runtime.h>
#include <cstdio>
#include <cstdint>


#define LAS __attribute__((address_space(3)))
#define DI __device__ __forceinline__
typedef unsigned short bf16_t;
typedef short bf16x8 __attribute__((ext_vector_type(8)));
typedef float f32x16 __attribute__((ext_vector_type(16)));
typedef float f32x4 __attribute__((ext_vector_type(4)));
typedef float f32x2 __attribute__((ext_vector_type(2)));
typedef __bf16 bf16x2n __attribute__((ext_vector_type(2)));
typedef unsigned u32x4 __attribute__((ext_vector_type(4)));
typedef unsigned u32x2 __attribute__((ext_vector_type(2)));

constexpr int NT = 512;
constexpr int LDS_BYTES = 163840;
constexpr int LDS_MISC = LDS_BYTES - 64;

constexpr int DM = 1024, NB = 4, SEQ = 4096, CTXL = 256, NH = 8;
constexpr int MLAT = NB * SEQ, MCTX = NB * CTXL, MALL = MLAT + MCTX;
constexpr int NKEY = SEQ + CTXL;
constexpr int NUNIT_B = NKEY / 16, NUNIT = NB * NUNIT_B;
constexpr float EPS = 1e-6f;
constexpr float ALPHA = 1.189207115002721f;
constexpr float QSCALE = 0.10206207261596577f * 1.4426950408889634f;

enum { I_X = 0, I_C, I_CTX, I_CCTX, I_WADA, I_BADA, I_WIN, I_QNG, I_KVNG, I_WUQ, I_WUKV, I_ARE, I_AIM, I_LOGDT, I_BRE, I_BIM, I_CRE, I_CIM,
       I_SSMD, I_WGLU, I_BGLU, I_GNA, I_GNS, I_WO, I_LN1G, I_LN1B, I_WRG, I_BRG, I_WRE, I_BRE2, I_WEG, I_WEU, I_WED, I_LN2G, I_LN2B, N_IN };

constexpr size_t MiB = 1u << 20;
constexpr size_t WS_CTL = 0;
constexpr size_t WS_MODP = 1 * MiB;
constexpr size_t WS_MOD = WS_MODP + 16 * 5 * 6144 * 4;
constexpr size_t WS_ROPEC = WS_MOD + 5 * 6144 * 4;
constexpr size_t WS_ROPES = WS_ROPEC + 4096 * 16 * 4;
constexpr size_t WS_PW = WS_ROPES + 4096 * 16 * 4;
constexpr size_t WS_BBAR = WS_PW + 64 * 64 * 20 * 8;
constexpr size_t WS_KC = WS_BBAR + 64 * 64 * 16 * 8;
constexpr size_t WS_WRT = WS_KC + 64 * 16 * 256 * 4;
constexpr size_t WS_TOKW = WS_WRT + 40 * 1024 * 4;
constexpr size_t WS_LIST = WS_TOKW + 16384 * 2 * 4;
constexpr size_t WS_WRH = WS_LIST + 32 * 16384 * 4;
constexpr size_t WS_WRL = WS_WRH + 64 * 1024 * 2;
constexpr size_t WS_STATS = WS_WRL + 64 * 1024 * 2;
constexpr size_t WS_SMALL_END = WS_STATS + 16384 * 2 * 4;
static_assert(WS_SMALL_END <= 9 * MiB, "small region");
constexpr size_t WS_WTIN = 9 * MiB;
constexpr size_t WS_WTO = 11 * MiB;
constexpr size_t WS_WTUQ = 13 * MiB;
constexpr size_t WS_WTUKV = WS_WTUQ + 768 * 256 * 2;
constexpr size_t WS_WTGLU = WS_WTUKV + 1024 * 128 * 2;
constexpr size_t WS_PWT = 14 * MiB + 256 * 1024;
static_assert(WS_WTGLU + 512 * 512 * 2 <= WS_PWT && WS_PWT + 64 * 20 * 64 * 8 <= 15 * MiB, "w region");
constexpr size_t WS_WEXP = 15 * MiB;
constexpr size_t WS_WGU = WS_WEXP, WS_WD = WS_WEXP + 32 * MiB;
constexpr size_t WS_M16 = 198 * MiB;
constexpr size_t WS_W3 = 248 * MiB;
constexpr size_t WS_ST = 63 * MiB;
constexpr size_t WS_XM = 63 * MiB;
constexpr size_t WS_P = 97 * MiB;
constexpr size_t WS_Q = 131 * MiB;
constexpr size_t WS_K = 155 * MiB;
constexpr size_t WS_KR = 173 * MiB;
constexpr size_t WS_VT = 181 * MiB;
constexpr size_t WS_G = 198 * MiB;
constexpr size_t WS_U2 = 114 * MiB;
constexpr size_t WS_MIX = 214 * MiB;
constexpr size_t WS_SSQP = 244 * MiB;
constexpr size_t WS_SSQA = 246 * MiB;
constexpr size_t WS_SSQS = 247 * MiB;
constexpr size_t WS_Y1B = 181 * MiB;
constexpr size_t WS_H = 63 * MiB;
constexpr size_t WS_Z = 97 * MiB;
constexpr size_t WS_F = 113 * MiB;
static_assert(WS_MIX + 32 * MiB <= 256 * MiB && WS_F + 64 * MiB <= WS_VT, "ws map");
constexpr int CW_CHK = 16, CW_CNT = 8192  , CW_BAR = 4096;
#define CNT_IDX(e) (CW_CNT + 64 * (e))
constexpr int CW_WOC = 512  ;
constexpr int CW_CARRYC = 15488  , CW_SSMC = 15552  ;
constexpr int CW_ZCNT = 13312  , CW_X1HEAD = 15424  ;
constexpr int CW_BGHEAD = 12288, CW_BGDONE = 12288 + 64;

struct Params { const float* in[N_IN]; float* out; unsigned char* ws; };

#define XB_TMO      128
#define XB_XCNT(j)  (256  + 64 * (j))
#define XB_XSUB(j)  (1280 + 64 * (j))
#define XB_XGEN(j)  (2304 + 64 * (j))
#define XB_TOP      3328
#define XB_TOPGEN   3392
#define XCD_BAR_WORDS 3456
#define XB_SPIN_CAP (1u << 18)
DI unsigned xb_ld(unsigned* p)              { return __hip_atomic_load(p, __ATOMIC_RELAXED, __HIP_MEMORY_SCOPE_AGENT); }
DI unsigned xb_add(unsigned* p, unsigned v) { return __hip_atomic_fetch_add(p, v, __ATOMIC_RELAXED, __HIP_MEMORY_SCOPE_AGENT); }
DI unsigned xb_xcc_id() { return (unsigned)__builtin_amdgcn_s_getreg((3 << 11) | 20) & 0xFu; }
#define XB_SPIN(cond, bar) do { unsigned _sp = 0; while (cond) { __builtin_amdgcn_s_sleep(1); \
    if ((++_sp & 255u) == 0u) { if (xb_ld(&(bar)[XB_TMO])) break; if (_sp > XB_SPIN_CAP) { atomicAdd(&(bar)[XB_TMO], 1u); break; } } } } while (0)
struct XcdBarrier { unsigned* bar; unsigned x; volatile LAS unsigned* st; };
DI XcdBarrier xcd_barrier_post(unsigned* bar, volatile LAS unsigned* st) {
    XcdBarrier b; b.bar = bar; b.x = xb_xcc_id(); b.st = st;
    if (threadIdx.x == 0) (void)xb_add(&bar[XB_XCNT(b.x)], 1u);
    return b;
}
DI void xcd_barrier_complete(unsigned* bar, unsigned x, unsigned& nloc, unsigned& nx) {
    const unsigned G = gridDim.x * gridDim.y * gridDim.z;
    unsigned sum, cnt, mine, sp = 0u;
    for (;;) {
        sum = 0u; cnt = 0u; mine = 0u;
#pragma unroll
        for (unsigned j = 0; j < 16; ++j) { const unsigned c = xb_ld(&bar[XB_XCNT(j)]); sum += c; cnt += (c > 0u) ? 1u : 0u; mine = (j == x) ? c : mine; }
        if (sum == G) break;
        __builtin_amdgcn_s_sleep(1);
        if ((++sp & 255u) == 0u) { if (xb_ld(&bar[XB_TMO])) break; if (sp > XB_SPIN_CAP) { atomicAdd(&bar[XB_TMO], 1u); break; } }
    }
    nloc = mine > 0u ? mine : 1u; nx = cnt > 0u ? cnt : 1u;
}
DI void xcd_barrier(const XcdBarrier& b) {
    asm volatile("s_waitcnt vmcnt(0)" ::: "memory");
    __syncthreads();
    if (threadIdx.x == 0) {
        unsigned* bar = b.bar;
        __builtin_amdgcn_s_waitcnt(0);
        unsigned nloc = b.st[0], nx = b.st[1];
        if (nloc == 0u) { xcd_barrier_complete(bar, b.x, nloc, nx); b.st[0] = nloc; b.st[1] = nx; }
        const unsigned old = xb_add(&bar[XB_XSUB(b.x)], 1u);
        const unsigned gen = old / nloc;
        if (old + 1u == (gen + 1u) * nloc) {
            __builtin_amdgcn_fence(__ATOMIC_RELEASE, "agent");
            asm volatile("s_waitcnt vmcnt(0)" ::: "memory");
            const unsigned og = xb_add(&bar[XB_TOP], 1u);
            const unsigned tg = og / nx;
            if (og + 1u == (tg + 1u) * nx) xb_add(&bar[XB_TOPGEN], 1u);
            else XB_SPIN(xb_ld(&bar[XB_TOPGEN]) == tg, bar);
            __builtin_amdgcn_fence(__ATOMIC_ACQUIRE, "agent");
            asm volatile("s_waitcnt vmcnt(0)" ::: "memory");
        } else {
            XB_SPIN(xb_ld(&bar[XB_TOPGEN]) == gen, bar);
            __builtin_amdgcn_fence(__ATOMIC_ACQUIRE, "agent");
            asm volatile("s_waitcnt vmcnt(0)" ::: "memory");
        }
    }
    __syncthreads();
}

DI float bf2f(bf16_t u) { return __uint_as_float((unsigned)u << 16); }
DI bf16_t f2bf(float f) { unsigned u = __float_as_uint(f); return (bf16_t)((u + 0x7fffu + ((u >> 16) & 1u)) >> 16); }
DI unsigned pk2(float lo, float hi) { f32x2 v = {lo, hi}; bf16x2n r = __builtin_convertvector(v, bf16x2n); return __builtin_bit_cast(unsigned, r); }
DI float lo16(unsigned u) { return __uint_as_float(u << 16); }
DI u32x4 widen_pair(u32x2 a, u32x2 b) {
    const auto r0 = __builtin_amdgcn_permlane32_swap(a.x, b.x, false, false); const auto r1 = __builtin_amdgcn_permlane32_swap(a.y, b.y, false, false);
    return (u32x4){r0[0], r1[0], r0[1], r1[1]};
}
DI void store16_wt(void* p, u32x4 v) { __hip_atomic_store((unsigned long long*)p, (unsigned long long)v.x | ((unsigned long long)v.y << 32), __ATOMIC_RELAXED, __HIP_MEMORY_SCOPE_AGENT); __hip_atomic_store((unsigned long long*)p + 1, (unsigned long long)v.z | ((unsigned long long)v.w << 32), __ATOMIC_RELAXED, __HIP_MEMORY_SCOPE_AGENT); }
DI float hi16(unsigned u) { return __uint_as_float(u & 0xffff0000u); }
DI float wave_sum(float v) {
#pragma unroll
    for (int o = 1; o < 64; o <<= 1) v += __shfl_xor(v, o);
    return v;
}
template <int CTRL> DI float dpp_f(float v) { return __int_as_float(__builtin_amdgcn_update_dpp(0, __float_as_int(v), CTRL, 0xF, 0xF, false)); }
DI float wave_sum_fast(float v) {
    v += dpp_f<0xB1>(v);
    v += dpp_f<0x4E>(v);
    v += dpp_f<0x141>(v);
    v += dpp_f<0x140>(v);
    return __int_as_float(__builtin_amdgcn_readlane(__float_as_int(v), 0)) + __int_as_float(__builtin_amdgcn_readlane(__float_as_int(v), 16)) +
           __int_as_float(__builtin_amdgcn_readlane(__float_as_int(v), 32)) + __int_as_float(__builtin_amdgcn_readlane(__float_as_int(v), 48));
}
DI float sigmoidf_(float x) { return __builtin_amdgcn_rcpf(1.f + __builtin_amdgcn_exp2f(-1.4426950408889634f * x)); }
DI float siluf_(float x) { return x * sigmoidf_(x); }
DI float geluf_(float x) { const float z2 = 1.5957691216057308f * (x + 0.044715f * x * x * x); return x * __builtin_amdgcn_rcpf(1.f + __builtin_amdgcn_exp2f(-1.4426950408889634f * z2)); }
DI int unit_row0(int u) { const int b = u / NUNIT_B, c = u % NUNIT_B; return c < 16 ? MLAT + b * CTXL + 16 * c : b * SEQ + 16 * (c - 16); }

struct Ctx {
    Params p; LAS unsigned char* lds; int tid, lane, wid, bid, G, vb;
    DI const float* in(int i) const {
        typedef const float* __attribute__((address_space(4))) const* kap_t; return ((kap_t)__builtin_amdgcn_kernarg_segment_ptr())[i]; }
    template <class T> DI T* ws(size_t off) const { return (T*)(p.ws + off); }
};

DI void publish_release(const Ctx& c, unsigned* cnt) {
    asm volatile("s_waitcnt vmcnt(0)" ::: "memory");
    __syncthreads();
    if (c.tid == 0) { __builtin_amdgcn_fence(__ATOMIC_RELEASE, "agent"); asm volatile("s_waitcnt vmcnt(0)" ::: "memory"); xb_add(cnt, 1u); }
}
DI void publish_wt(const Ctx& c, unsigned* cnt) {
    asm volatile("s_waitcnt vmcnt(0)" ::: "memory");
    __syncthreads();
    if (c.tid == 0) xb_add(cnt, 1u);
}
DI void wait_acquire(const Ctx& c, unsigned* cnt, unsigned need) {
    if (c.tid == 0) {
        unsigned* bar = c.ws<unsigned>(WS_CTL) + CW_BAR;
        XB_SPIN(xb_ld(cnt) < need, bar);
        __builtin_amdgcn_fence(__ATOMIC_ACQUIRE, "agent");
        asm volatile("s_waitcnt vmcnt(0)" ::: "memory");
    }
    __syncthreads();
}

constexpr int GBM = 256, GBN = 128, GROW = 128, G_ASTAGE = GBM * GROW, G_WSTAGE = GBN * GROW, G_STAGE = G_ASTAGE + G_WSTAGE;
constexpr int G_SCR = 3 * G_STAGE;
#define MFMA32(a, b, c) __builtin_amdgcn_mfma_f32_32x32x16_bf16((a), (b), (c), 0, 0, 0)

#define GLDS16(gp, lp) __builtin_amdgcn_global_load_lds((const unsigned*)(gp), (LAS unsigned*)(lp), 16, 0, 0)
#define RAW_BARRIER() do { asm volatile("s_waitcnt lgkmcnt(0)" ::: "memory"); __builtin_amdgcn_s_barrier(); } while (0)
template <int PROBE = 0, class AL, class WL, class EPI>
DI void gemm_tile(const Ctx& c, AL& al, WL& wl, int m0, int n0, int K, EPI& epi, const LAS float* midscale, int midk) {
    const int lane = c.lane, wid = c.wid, r = lane & 31, h = lane >> 5, wm = wid & 3, wn = wid >> 2;
    f32x16 acc[2][2];
#pragma unroll
    for (int i = 0; i < 2; ++i)
#pragma unroll
        for (int j = 0; j < 2; ++j)
#pragma unroll
            for (int e = 0; e < 16; ++e) acc[i][j][e] = 0.f;
    const int l8 = lane >> 3, p8 = lane & 7;
    int ak[4], wk[2];
#pragma unroll
    for (int i = 0; i < 4; ++i) { const int row = wid * 32 + i * 8 + l8; al.init(i, m0 + row); ak[i] = (p8 ^ ((row >> 1) & 7)) * 8; }
#pragma unroll
    for (int i = 0; i < 2; ++i) { const int row = wid * 16 + i * 8 + l8; wl.init(i, n0 + row); wk[i] = (p8 ^ ((row >> 1) & 7)) * 8; }
    LAS unsigned char* ldA = c.lds + wid * 32 * GROW;
    LAS unsigned char* ldW = c.lds + G_ASTAGE + wid * 16 * GROW;
    const int nk = K / 64;
#define GEMM_ISSUE(KT, BUF)                                                                                            \
    { const int k0_ = (KT) * 64; LAS unsigned char* a_ = ldA + (BUF) * G_STAGE; LAS unsigned char* w_ = ldW + (BUF) * G_STAGE; \
      _Pragma("unroll") for (int i = 0; i < 4; ++i) GLDS16(al.ptr(i, k0_ + ak[i]), a_ + i * 8 * GROW);                \
      _Pragma("unroll") for (int i = 0; i < 2; ++i) GLDS16(wl.ptr(i, k0_ + wk[i]), w_ + i * 8 * GROW); }
    const int sx = (r >> 1) & 7;
    int fo[4];
#pragma unroll
    for (int ks = 0; ks < 4; ++ks) fo[ks] = ((2 * ks + h) ^ sx) * 16;
    const LAS unsigned char* sa0 = c.lds + (wm * 64 + r) * GROW;
    const LAS unsigned char* sw0 = c.lds + G_ASTAGE + (wn * 64 + r) * GROW;
    RAW_BARRIER();
    GEMM_ISSUE(0, 0)
    GEMM_ISSUE(1, 1)
#define GEMM_FRAG(KS, A0, A1, W0, W1) const bf16x8 A0 = *(const LAS bf16x8*)(sa + fo[KS]), A1 = *(const LAS bf16x8*)(sa + 32 * GROW + fo[KS]), \
                                                   W0 = *(const LAS bf16x8*)(sw + fo[KS]), W1 = *(const LAS bf16x8*)(sw + 32 * GROW + fo[KS]);
#define GEMM_MMA(A0, A1, W0, W1) { acc[0][0] = MFMA32(W0, A0, acc[0][0]); acc[0][1] = MFMA32(W0, A1, acc[0][1]); acc[1][0] = MFMA32(W1, A0, acc[1][0]); acc[1][1] = MFMA32(W1, A1, acc[1][1]); }
    if (nk > 1) asm volatile("s_waitcnt vmcnt(6)" ::: "memory"); else asm volatile("s_waitcnt vmcnt(0)" ::: "memory");
    RAW_BARRIER();
    if (2 < nk) GEMM_ISSUE(2, 2)
    bf16x8 pa0 = *(const LAS bf16x8*)(sa0 + fo[0]), pa1 = *(const LAS bf16x8*)(sa0 + 32 * GROW + fo[0]), pw0 = *(const LAS bf16x8*)(sw0 + fo[0]), pw1 = *(const LAS bf16x8*)(sw0 + 32 * GROW + fo[0]);
    int buf = 0;
    for (int kt = 0; kt < nk; ++kt) {
        const LAS unsigned char* sa = sa0 + buf * G_STAGE; const LAS unsigned char* sw = sw0 + buf * G_STAGE;
        GEMM_FRAG(1, b0, b1, x0, x1)
        GEMM_MMA(pa0, pa1, pw0, pw1)
        __builtin_amdgcn_sched_barrier(0);
        GEMM_FRAG(2, c0, c1, y0, y1)
        GEMM_MMA(b0, b1, x0, x1)
        __builtin_amdgcn_sched_barrier(0);
        GEMM_FRAG(3, d0, d1, z0, z1)
        GEMM_MMA(c0, c1, y0, y1)
        __builtin_amdgcn_sched_barrier(0);
        const int nb = buf == 2 ? 0 : buf + 1;
        if (kt + 1 < nk) {
            if (kt + 2 < nk) asm volatile("s_waitcnt vmcnt(6)" ::: "memory"); else asm volatile("s_waitcnt vmcnt(0)" ::: "memory");
            RAW_BARRIER();
            if (kt + 3 < nk) GEMM_ISSUE(kt + 3, buf)
            const LAS unsigned char* na = sa0 + nb * G_STAGE; const LAS unsigned char* nw = sw0 + nb * G_STAGE;
            pa0 = *(const LAS bf16x8*)(na + fo[0]); pa1 = *(const LAS bf16x8*)(na + 32 * GROW + fo[0]); pw0 = *(const LAS bf16x8*)(nw + fo[0]); pw1 = *(const LAS bf16x8*)(nw + 32 * GROW + fo[0]);
        }
        __builtin_amdgcn_sched_barrier(0);
        GEMM_MMA(d0, d1, z0, z1)
        if (midscale != nullptr && kt == midk) {
            const float s0 = midscale[wm * 64 + r], s1 = midscale[wm * 64 + 32 + r];
#pragma unroll
            for (int e = 0; e < 16; ++e) { acc[0][0][e] *= s0; acc[1][0][e] *= s0; acc[0][1][e] *= s1; acc[1][1][e] *= s1; }
        }
        buf = nb;
    }
#undef GEMM_FRAG
#undef GEMM_MMA
#undef GEMM_ISSUE
    if constexpr (EPI::STAGED) {
        if (!(PROBE & 4)) {
            RAW_BARRIER();
            LAS float* reg = (LAS float*)(c.lds + wid * 17408);
#pragma unroll
            for (int im = 0; im < 2; ++im)
#pragma unroll
                for (int in = 0; in < 2; ++in)
#pragma unroll
                    for (int g = 0; g < 4; ++g) *(LAS f32x4*)(reg + (im * 32 + r) * 68 + in * 32 + 8 * g + 4 * h) = (f32x4){acc[in][im][4 * g], acc[in][im][4 * g + 1], acc[in][im][4 * g + 2], acc[in][im][4 * g + 3]};
            asm volatile("s_waitcnt lgkmcnt(0)" ::: "memory");
            const int rr = lane >> 4, cc = (lane & 15) * 4;
            if constexpr (EPI::STAGED == 2) { epi.staged(reg, lane, m0 + wm * 64, n0 + wn * 64, wm * 64); } else
#pragma unroll 4
            for (int j = 0; j < 16; ++j) { const int row = 4 * j + rr; const f32x4 v = *(const LAS f32x4*)(reg + row * 68 + cc);
                epi.chunk(m0 + wm * 64 + row, n0 + wn * 64 + cc, v, wm * 64 + row); }
        }
    } else {
        if (!(PROBE & 4)) epi.run(acc, m0 + wm * 64 + r, n0 + wn * 64, h, wm * 64 + r);
    }
    if (false) {}
    else { asm volatile("" :: "v"(acc[0][0]), "v"(acc[0][1]), "v"(acc[1][0]), "v"(acc[1][1])); }
}

constexpr int H_ROW = 64, H_ASTAGE = 256 * H_ROW, H_STAGE = 2 * H_ASTAGE;
template <class EPI>
DI void gemm_tile256(const Ctx& c, const bf16_t* A, int lda, const bf16_t* W, int ldw, int m0, int n0, int K, EPI& epi, const LAS float* midscale, int midk) {
    const int lane = c.lane, wid = c.wid, r = lane & 31, h = lane >> 5, wm = wid & 1, wn = wid >> 1;
    f32x16 acc[2][4];
#pragma unroll
    for (int i = 0; i < 2; ++i)
#pragma unroll
        for (int j = 0; j < 4; ++j)
#pragma unroll
            for (int e = 0; e < 16; ++e) acc[i][j][e] = 0.f;
    const int prow = lane >> 2, ppos = lane & 3;
    const bf16_t* asrc[2]; const bf16_t* wsrc[2];
#pragma unroll
    for (int i = 0; i < 2; ++i) { const int row = (2 * wid + i) * 16 + prow; const int ch = ppos ^ ((row >> 2) & 3);
        asrc[i] = A + (size_t)(m0 + row) * lda + ch * 8; wsrc[i] = W + (size_t)(n0 + row) * ldw + ch * 8; }
    LAS unsigned char* ldA = c.lds + (2 * wid) * 1024;
    LAS unsigned char* ldW = c.lds + H_ASTAGE + (2 * wid) * 1024;
    const int nk = K / 32;
#define H_ISSUE(KT, BUF) { const int k0_ = (KT) * 32; LAS unsigned char* a_ = ldA + (BUF) * H_STAGE; LAS unsigned char* w_ = ldW + (BUF) * H_STAGE; \
      GLDS16(asrc[0] + k0_, a_); GLDS16(asrc[1] + k0_, a_ + 1024); GLDS16(wsrc[0] + k0_, w_); GLDS16(wsrc[1] + k0_, w_ + 1024); }
    const int sx = (r >> 2) & 3;
    const int fo0 = ((0 + h) ^ sx) * 16, fo1 = ((2 + h) ^ sx) * 16;
    const LAS unsigned char* sa0 = c.lds + (wm * 128 + r) * H_ROW;
    const LAS unsigned char* sw0 = c.lds + H_ASTAGE + (wn * 64 + r) * H_ROW;
    RAW_BARRIER();
    H_ISSUE(0, 0) H_ISSUE(1, 1) H_ISSUE(2, 2)
    int buf = 0;
    for (int kt = 0; kt < nk; ++kt) {
        if (kt + 2 < nk) asm volatile("s_waitcnt vmcnt(8)" ::: "memory"); else if (kt + 1 < nk) asm volatile("s_waitcnt vmcnt(4)" ::: "memory"); else asm volatile("s_waitcnt vmcnt(0)" ::: "memory");
        RAW_BARRIER();
        if (kt + 3 < nk) { const int nb = (buf + 3) & 3; H_ISSUE(kt + 3, nb) }
        const LAS unsigned char* sa = sa0 + buf * H_STAGE; const LAS unsigned char* sw = sw0 + buf * H_STAGE;
#pragma unroll
        for (int ks = 0; ks < 2; ++ks) {
            const int fo = ks ? fo1 : fo0;
            bf16x8 af[4], wf[2];
#pragma unroll
            for (int im = 0; im < 4; ++im) af[im] = *(const LAS bf16x8*)(sa + im * 32 * H_ROW + fo);
#pragma unroll
            for (int in = 0; in < 2; ++in) wf[in] = *(const LAS bf16x8*)(sw + in * 32 * H_ROW + fo);
#pragma unroll
            for (int in = 0; in < 2; ++in)
#pragma unroll
                for (int im = 0; im < 4; ++im) acc[in][im] = MFMA32(wf[in], af[im], acc[in][im]);
        }
        if (midscale != nullptr && kt == midk) {
#pragma unroll
            for (int im = 0; im < 4; ++im) { const float s = midscale[wm * 128 + im * 32 + r];
#pragma unroll
                for (int e = 0; e < 16; ++e) { acc[0][im][e] *= s; acc[1][im][e] *= s; } }
        }
        buf = (buf + 1) & 3;
    }
#undef H_ISSUE
    LAS float* reg = (LAS float*)(c.lds + wid * 17408);
    const int rr = lane >> 4, cc = (lane & 15) * 4;
#pragma unroll
    for (int hf = 0; hf < 2; ++hf) {
        RAW_BARRIER();
#pragma unroll
        for (int q = 0; q < 2; ++q)
#pragma unroll
            for (int in = 0; in < 2; ++in)
#pragma unroll
                for (int g = 0; g < 4; ++g) { const f32x16& v = acc[in][hf * 2 + q];
                    *(LAS f32x4*)(reg + (q * 32 + r) * 68 + in * 32 + 8 * g + 4 * h) = (f32x4){v[4 * g], v[4 * g + 1], v[4 * g + 2], v[4 * g + 3]}; }
        asm volatile("s_waitcnt lgkmcnt(0)" ::: "memory");
#pragma unroll 4
        for (int j = 0; j < 16; ++j) { const int row = 4 * j + rr; const f32x4 v = *(const LAS f32x4*)(reg + row * 68 + cc);
            epi.chunk(m0 + wm * 128 + hf * 64 + row, n0 + wn * 64 + cc, v, wm * 128 + hf * 64 + row); }
    }
}

template <int NR> struct RowLoader {
    const bf16_t* base; int ld, nrows; const bf16_t* rp[NR];
    DI void init(int i, int row) { rp[i] = base + (size_t)(row < nrows ? row : nrows - 1) * ld; }
    DI const bf16_t* ptr(int i, int k) const { return rp[i] + k; }
};

DI int maprow(int mode, int j) {
    if (mode == 1) return j < 416 ? j : j + 96;
    if (mode == 2) return 64 * (j >> 5) + (j & 31);
    if (mode == 3) return 64 * (j >> 5) + 32 + (j & 31);
    return j;
}
DI void tr_tile(const Ctx& c, const float* src, int ldsrc, int k0, int j0, bf16_t* dst, int lddst, int mode, const float* gain, bool nts = false) {
    LAS float* scr = (LAS float*)c.lds;
    __syncthreads();
    {
        const int jj = c.tid & 63;
        const bool ok = (j0 + jj) < ldsrc;
#pragma unroll
        for (int i = 0; i < 8; ++i) {
            const int kk = i * 8 + (c.tid >> 6);
            float v = ok ? __builtin_nontemporal_load(src + (size_t)(k0 + kk) * ldsrc + j0 + jj) : 0.f;
            if (gain) v *= gain[k0 + kk];
            scr[kk * 65 + jj] = v;
        }
    }
    __syncthreads();
    {
        const int jj = c.tid >> 3, kc = c.tid & 7;
        if (j0 + jj < ldsrc) {
            const LAS float* s = scr + (kc * 8) * 65 + jj;
            u32x4 o; o.x = pk2(s[0], s[65]); o.y = pk2(s[2 * 65], s[3 * 65]); o.z = pk2(s[4 * 65], s[5 * 65]); o.w = pk2(s[6 * 65], s[7 * 65]);
            u32x4* dp = (u32x4*)(dst + (size_t)maprow(mode, j0 + jj) * lddst + k0 + kc * 8);
            if (nts) __builtin_nontemporal_store(o, dp); else *dp = o;
        }
    }
}

DI void tr_strip(const Ctx& c, const float* src, int ldsrc, int k0, int n0, bf16_t* dst, int lddst, const float* gain) {
    LAS float* scr = (LAS float*)c.lds;
    f32x4 v[8];
#pragma unroll
    for (int i = 0; i < 8; ++i) v[i] = __builtin_nontemporal_load((const f32x4*)(src + (size_t)(k0 + c.wid * 8 + i) * ldsrc + n0 + c.lane * 4));
    if (gain) {
#pragma unroll
        for (int i = 0; i < 8; ++i) v[i] = v[i] * gain[k0 + c.wid * 8 + i];
    }
    __syncthreads();
#pragma unroll
    for (int i = 0; i < 8; ++i) *(LAS f32x4*)(scr + (c.wid * 8 + i) * 260 + c.lane * 4) = v[i];
    __syncthreads();
    const int n = c.tid >> 1, half = c.tid & 1;
    const LAS float* s = scr + (half * 32) * 260 + n;
    u32x4* dp = (u32x4*)(dst + (size_t)(n0 + n) * lddst + k0 + half * 32);
#pragma unroll
    for (int q = 0; q < 4; ++q) { u32x4 o; o.x = pk2(s[(8 * q) * 260], s[(8 * q + 1) * 260]); o.y = pk2(s[(8 * q + 2) * 260], s[(8 * q + 3) * 260]);
        o.z = pk2(s[(8 * q + 4) * 260], s[(8 * q + 5) * 260]); o.w = pk2(s[(8 * q + 6) * 260], s[(8 * q + 7) * 260]); dp[q] = o; }
}

DI void prep_item(const Ctx& c, int it0) {
    constexpr int N_MODP = 16 * 12, N_ROPE = 128, N_SSM0 = 64, N_WIN = 16 * 15, N_WO = 16 * 4, N_WUQ = 4 * 3, N_WUKV = 2 * 4, N_WGLU = 8 * 2, N_RT = 64, N_MISC = 1;
    constexpr int TOT = N_MODP + N_ROPE + N_SSM0 + N_WIN + N_WO + N_WUQ + N_WUKV + N_WGLU + N_RT + N_MISC;

        int it = it0;
        if (it < N_MODP) {
            const int kc = it / 12, jb = it % 12;
            LAS float* sv = (LAS float*)c.lds;
            LAS float* red = (LAS float*)(c.lds + 2048);
            const int cg = c.tid & 127, kq = c.tid >> 7;
            const float* w = c.in(I_WADA) + (size_t)(kc * 64 + kq * 16) * 6144 + jb * 512 + cg * 4;
            f32x4 wv[16];
#pragma unroll
            for (int k = 0; k < 16; ++k) wv[k] = __builtin_nontemporal_load((const f32x4*)(w + (size_t)k * 6144));
            __syncthreads();
            if (c.tid < 320) { const int r = c.tid / 64, k = kc * 64 + (c.tid & 63); const float v = r < 4 ? c.in(I_C)[r * 1024 + k] : c.in(I_CCTX)[k]; sv[c.tid] = siluf_(v); }
            __syncthreads();
            f32x4 a[5];
#pragma unroll
            for (int r = 0; r < 5; ++r) a[r] = (f32x4){0.f, 0.f, 0.f, 0.f};
#pragma unroll
            for (int k = 0; k < 16; ++k)
#pragma unroll
                for (int r = 0; r < 5; ++r) a[r] += sv[r * 64 + kq * 16 + k] * wv[k];
#pragma unroll
            for (int r = 0; r < 5; ++r) *(LAS f32x4*)(red + (kq * 5 + r) * 512 + cg * 4) = a[r];
            __syncthreads();
            float* mp = c.ws<float>(WS_MODP) + (size_t)kc * 5 * 6144 + jb * 512;
#pragma unroll
            for (int r = 0; r < 5; ++r) { const int j = c.tid; mp[r * 6144 + j] = (red[(0 * 5 + r) * 512 + j] + red[(1 * 5 + r) * 512 + j]) + (red[(2 * 5 + r) * 512 + j] + red[(3 * 5 + r) * 512 + j]); }
            return;
        }
        it -= N_MODP;
        if (it < N_ROPE) {
            const int idx = it * 512 + c.tid, t = idx >> 4, i = idx & 15;
            const int pos = (i < 8) ? (t >> 6) : (t & 63);
            const float inv = exp2f(-(float)(i & 7) * (13.287712379549449f / 8.0f));
            const float ang = (float)pos * inv;
            float sn, cs; sincosf(ang, &sn, &cs);
            c.ws<float>(WS_ROPEC)[idx] = cs; c.ws<float>(WS_ROPES)[idx] = sn;
            return;
        }
        it -= N_ROPE;
        if (it < N_SSM0) {
            const int dg = it;
            LAS f32x2* lp = (LAS f32x2*)c.lds;
            LAS double* lcd = (LAS double*)(c.lds + 16384);
            __syncthreads();
            if (c.tid < 64) {
                const int p = c.tid, idx = dg * 64 + p;
                const double are = c.in(I_ARE)[idx], aim = c.in(I_AIM)[idx], dt = exp((double)c.in(I_LOGDT)[dg]);
                const double mag = exp(are * dt), abr = mag * cos(aim * dt), abi = mag * sin(aim * dt);
                double pr = 1.0, pi = 0.0;
                for (int k = 0; k <= 16; ++k) { lp[p * 17 + k] = (f32x2){(float)pr, (float)pi}; const double nr = pr * abr - pi * abi, ni = pr * abi + pi * abr; pr = nr; pi = ni; }
                const double den = are * are + aim * aim, nre = abr - 1.0;
                lcd[p * 2] = (nre * are + abi * aim) / den; lcd[p * 2 + 1] = (abi * are - nre * aim) / den;
            }
            __syncthreads();
            float2* pw = c.ws<float2>(WS_PW) + (size_t)dg * 64 * 20; float2* pwt = c.ws<float2>(WS_PWT) + (size_t)dg * 20 * 64;
            for (int t = c.tid; t < 64 * 17; t += NT) { const int p = t / 17, k = t % 17; const f32x2 v = lp[t]; pw[p * 20 + k] = make_float2(v.x, v.y); }
            for (int t = c.tid; t < 17 * 64; t += NT) { const int k = t >> 6, p = t & 63; const f32x2 v = lp[p * 17 + k]; pwt[k * 64 + p] = make_float2(v.x, v.y); }
            float2* bb = c.ws<float2>(WS_BBAR) + (size_t)dg * 1024;
#pragma unroll
            for (int q = 0; q < 2; ++q) { const int i = c.tid + q * 512, p = i >> 4;
                const double cre = lcd[p * 2], cim = lcd[p * 2 + 1], br = c.in(I_BRE)[(size_t)dg * 1024 + i], bi = c.in(I_BIM)[(size_t)dg * 1024 + i];
                bb[i] = make_float2((float)(cre * br - cim * bi), (float)(cre * bi + cim * br)); }
            return;
        }
        it -= N_SSM0;
        if (it < N_WIN) { const int kb = it / 15, jb = it % 15; tr_tile(c, c.in(I_WIN), 928, kb * 64, jb * 64, c.ws<bf16_t>(WS_WTIN), 1024, 1, nullptr); return; }
        it -= N_WIN;
        if (it < N_WO) { const int kb = it >> 2, q = it & 3; tr_strip(c, c.in(I_WO), 1024, kb * 64, q * 256, c.ws<bf16_t>(WS_WTO), 1024, kb < 8 ? c.in(I_GNA) : c.in(I_GNS) - 512); return; }
        it -= N_WO;
        if (it < N_WUQ) { const int kb = it / 3, q = it % 3; tr_strip(c, c.in(I_WUQ), 768, kb * 64, q * 256, c.ws<bf16_t>(WS_WTUQ), 256, c.in(I_QNG)); return; }
        it -= N_WUQ;
        if (it < N_WUKV) { const int kb = it >> 2, q = it & 3; tr_strip(c, c.in(I_WUKV), 1024, kb * 64, q * 256, c.ws<bf16_t>(WS_WTUKV), 128, c.in(I_KVNG)); return; }
        it -= N_WUKV;
        if (it < N_WGLU) { const int kb = it >> 1, q = it & 1; tr_strip(c, c.in(I_WGLU), 512, kb * 64, q * 256, c.ws<bf16_t>(WS_WTGLU), 512, nullptr); return; }
        it -= N_WGLU;
        if (it < N_RT) {
            const int e = it & 31, q = it >> 5;
            { const int k = c.tid + q * 512; const float w = c.in(I_WRE)[k * 32 + e];
              const size_t off = ((size_t)((k >> 7) * 8 + ((k >> 4) & 7)) * 64 + ((k >> 3) & 1) * 32 + e) * 8 + (k & 7);
              const bf16_t hi = f2bf(w); c.ws<bf16_t>(WS_WRH)[off] = hi; c.ws<bf16_t>(WS_WRL)[off] = f2bf(w - bf2f(hi)); }
            return;
        }
        it -= N_RT;
        {
            bf16_t* wt = c.ws<bf16_t>(WS_WTIN);
            for (int i = c.tid; i < 96 * 1024 / 8; i += NT) ((u32x4*)(wt + 416 * 1024))[i] = (u32x4){0u, 0u, 0u, 0u};
        }
    }
constexpr int PREP_EARLY = 192 + 64 + 240 + 1, PREP_LATE = 128 + 164;
DI int prep_early_index(int e) { return e < 192 ? e : (e < 256 ? 320 + (e - 192) : (e < 496 ? 384 + (e - 256) : 788)); }
DI int prep_late_index(int l) { return l < 128 ? 192 + l : 624 + (l - 128); }
DI void stage_prep(const Ctx& c) {
    for (int e = c.bid; e < PREP_EARLY; e += c.G) prep_item(c, prep_early_index(e));
}

DI void stage_s1(const Ctx& c) {
    const int gt = c.bid * NT + c.tid, GT = c.G * NT;
    for (int i = gt; i < 5 * 6144; i += GT) {
        const int j = i % 6144; float s = c.in(I_BADA)[j];
#pragma unroll
        for (int kc = 0; kc < 16; ++kc) s += c.ws<float>(WS_MODP)[(size_t)kc * 5 * 6144 + i];
        c.ws<float>(WS_MOD)[i] = s;
    }
    {
        const float* modp = c.ws<float>(WS_MODP);
        const int rpb = (MALL + c.G - 1) / c.G, r0 = c.bid * rpb, r1 = (r0 + rpb < MALL) ? r0 + rpb : MALL;
        if (r0 < MALL) {
            const int mrA = r0 < MLAT ? r0 / SEQ : 4, mrB = (r1 - 1) < MLAT ? (r1 - 1) / SEQ : 4;
            LAS float* mv = (LAS float*)(c.lds + 32768);
            __syncthreads();
            for (int set = 0; set < (mrA == mrB ? 1 : 2); ++set) {
                const int mr = set ? mrB : mrA; float sv[4];
#pragma unroll
                for (int q = 0; q < 4; ++q) { const int col = c.tid + q * 512; sv[q] = c.in(I_BADA)[col] + (col >= 1024 ? 1.f : 0.f); }
#pragma unroll
                for (int kc = 0; kc < 16; ++kc)
#pragma unroll
                    for (int q = 0; q < 4; ++q) sv[q] += modp[(kc * 5 + mr) * 6144 + c.tid + q * 512];
#pragma unroll
                for (int q = 0; q < 4; ++q) mv[set * 2048 + c.tid + q * 512] = sv[q];
            }
            __syncthreads();
            for (int rb = r0 + c.wid; rb < r1; rb += 24) {
                f32x4 v[3][4];
#pragma unroll
                for (int q = 0; q < 3; ++q) { const int row = rb + 8 * q; if (row < r1) {
                    const float* src = row < MLAT ? c.in(I_X) + (size_t)row * 1024 : c.in(I_CTX) + (size_t)(row - MLAT) * 1024;
#pragma unroll
                    for (int j = 0; j < 4; ++j) v[q][j] = __builtin_nontemporal_load((const f32x4*)(src + (c.lane + 64 * j) * 4)); } }
#pragma unroll
                for (int q = 0; q < 3; ++q) { const int row = rb + 8 * q; if (row < r1) {
                    const int mr = row < MLAT ? row / SEQ : 4; const LAS float* ms = mv + (mr == mrA ? 0 : 2048);
                    bf16_t* dst = c.ws<bf16_t>(WS_XM) + (size_t)row * 1024;
#pragma unroll
                    for (int j = 0; j < 4; ++j) { const int n = (c.lane + 64 * j) * 4;
                        const f32x4 sh = *(const LAS f32x4*)(ms + n), sc = *(const LAS f32x4*)(ms + 1024 + n), x = v[q][j] * sc + sh;
                        u32x2 o; o.x = pk2(x.x, x.y); o.y = pk2(x.z, x.w); *(u32x2*)(dst + n) = o; } } }
            }
        }
    }
    const float2* pw = c.ws<float2>(WS_PW); const float2* bbar = c.ws<float2>(WS_BBAR);
    LAS f32x2* lpw = (LAS f32x2*)c.lds;
    LAS f32x2* lbb = lpw + 256;
    LAS float* lcr = (LAS float*)(lbb + 1024);
    LAS float* lci = lcr + 1024;
    for (int it = c.bid; it < 256; it += c.G) {
        const int dg = it >> 2, lq = it & 3;
        __syncthreads();
        if (c.tid < 256) { const int p = c.tid >> 2, l = c.tid & 3; const float2 a = pw[(size_t)(dg * 64 + p) * 20 + lq * 4 + l]; lpw[c.tid] = (f32x2){a.x, a.y}; }
        for (int i = c.tid; i < 1024; i += NT) { const float2 b = bbar[(size_t)dg * 1024 + i]; lbb[i] = (f32x2){b.x, b.y}; lcr[i] = c.in(I_CRE)[(size_t)dg * 1024 + i]; lci[i] = c.in(I_CIM)[(size_t)dg * 1024 + i]; }
        __syncthreads();
#pragma unroll
        for (int q = 0; q < 2; ++q) {
            const int i = c.tid + q * 512, hp = i & 15, hh = (i >> 4) & 15, l = i >> 8;
            float s = 0.f;
#pragma unroll 16
            for (int p = 0; p < 64; ++p) { const f32x2 a = lpw[p * 4 + l], b = lbb[p * 16 + hp];
                s += lcr[hh * 64 + p] * (a.x * b.x - a.y * b.y) - lci[hh * 64 + p] * (a.x * b.y + a.y * b.x); }
            c.ws<float>(WS_KC)[(size_t)(dg * 16 + lq * 4 + l) * 256 + hh * 16 + hp] = s;
        }
    }
}

template <int PROBE = 0> DI void inproj_tile(const Ctx& c, int mt, int nt);
DI void m16_chunk(const Ctx& c, int chunk) {
    const float2* pw = c.ws<float2>(WS_PW); const float2* bbar = c.ws<float2>(WS_BBAR);
#pragma unroll
    for (int qq = 0; qq < 8; ++qq) {
        const int i = chunk * 4096 + qq * 512 + c.tid;
        float v2[2];
#pragma unroll
        for (int q = 0; q < 2; ++q) { const int ii = 2 * i + q, k = ii & 255, n = (ii >> 8) & 255, g = ii >> 16;
            const int d = n >> 7, p = (n >> 1) & 63, ri = n & 1, j = k >> 4, hp = k & 15, dg = d * 32 + g, e = d ? j : 15 - j;
            const float2 a = pw[(size_t)(dg * 64 + p) * 20 + e], b = bbar[(size_t)(dg * 64 + p) * 16 + hp];
            v2[q] = ri ? (a.x * b.y + a.y * b.x) : (a.x * b.x - a.y * b.y); }
        c.ws<unsigned>(WS_M16)[i] = pk2(v2[0], v2[1]);
    }
}
DI void w3_chunk(const Ctx& c, int chunk) {
    const float2* pwt = c.ws<float2>(WS_PWT); const float* kc = c.ws<float>(WS_KC);
#pragma unroll
    for (int qq = 0; qq < 8; ++qq) {
        const int i2 = chunk * 4096 + qq * 512 + c.tid;
        float v2[2];
#pragma unroll
        for (int q = 0; q < 2; ++q) {
            const int idx = 2 * i2 + q, k = idx & 511, n = (idx >> 9) & 255, g = idx >> 17, i = n >> 4, hh = n & 15;
            float v;
            if (k < 256) {
                const int d = k >> 7, p = (k >> 1) & 63, ri = k & 1, dg = d * 32 + g, e = d ? 16 - i : i + 1;
                const float2 a = pwt[(size_t)(dg * 20 + e) * 64 + p];
                const float cr = c.in(I_CRE)[(size_t)(dg * 16 + hh) * 64 + p], ci = c.in(I_CIM)[(size_t)(dg * 16 + hh) * 64 + p];
                v = ri ? -(cr * a.y + ci * a.x) : (cr * a.x - ci * a.y);
            } else {
                const int j = (k - 256) >> 4, hp = (k - 256) & 15;
                const float k0 = kc[(size_t)((0 * 32 + g) * 16 + (j <= i ? i - j : 0)) * 256 + hh * 16 + hp];
                const float k1 = kc[(size_t)((1 * 32 + g) * 16 + (j >= i ? j - i : 0)) * 256 + hh * 16 + hp];
                v = (j <= i ? k0 : 0.f) + (j >= i ? k1 : 0.f);
                if (j == i && hp == hh) v += c.in(I_SSMD)[g * 16 + hh];
            }
            v2[q] = v;
        }
        c.ws<unsigned>(WS_W3)[i2] = pk2(v2[0], v2[1]);
    }
}

constexpr int CONV_TILES = 32 * 192, CONV_PER = 2, CONV_ITEMS = CONV_TILES / CONV_PER;
DI void conv_tile(const Ctx& c, int it) {
    constexpr int PER_GU = 16 * 4, PER_D = 4 * 16;
    const int e = it / (2 * PER_GU + PER_D); int r = it % (2 * PER_GU + PER_D);
    if (r < PER_GU) { const int kb = r >> 2, jb = r & 3; tr_tile(c, c.in(I_WEG) + (size_t)e * 1024 * 256, 256, kb * 64, jb * 64, c.ws<bf16_t>(WS_WGU) + (size_t)e * 512 * 1024, 1024, 2, nullptr, true); return; }
    r -= PER_GU;
    if (r < PER_GU) { const int kb = r >> 2, jb = r & 3; tr_tile(c, c.in(I_WEU) + (size_t)e * 1024 * 256, 256, kb * 64, jb * 64, c.ws<bf16_t>(WS_WGU) + (size_t)e * 512 * 1024, 1024, 3, nullptr, true); return; }
    r -= PER_GU;
    { const int kb = r >> 4, jb = r & 15; tr_tile(c, c.in(I_WED) + (size_t)e * 256 * 1024, 1024, kb * 64, jb * 64, c.ws<bf16_t>(WS_WD) + (size_t)e * 1024 * 256, 256, 0, nullptr, true); }
}
DI void bg_run(const Ctx& c, int phase) {
    unsigned* ctl = c.ws<unsigned>(WS_CTL);
    volatile LAS unsigned* slot = (volatile LAS unsigned*)(c.lds + LDS_MISC) + 8;
    __syncthreads();
    if (phase < 0) {
        unsigned nxt = 0u; if (c.tid == 0) nxt = xb_add(&ctl[CW_BGHEAD], 2u);
        for (;;) {
            __syncthreads();
            if (c.tid == 0) *slot = nxt;
            __syncthreads();
            const unsigned item = *slot & 0xFFFFFu;
            if (item >= (unsigned)CONV_ITEMS) break;
            if (c.tid == 0) nxt = xb_add(&ctl[CW_BGHEAD], 2u);
#pragma unroll 1
            for (int q = 0; q < 2 * CONV_PER; ++q) if ((int)item * CONV_PER + q < CONV_TILES) conv_tile(c, (int)item * CONV_PER + q);
        }
        return;
    }
    if (c.tid == 0) { const unsigned last = xb_add(&ctl[CW_BGDONE + 64 * phase], 1u) == (unsigned)c.G - 1u ? 1u : 0u; if (last) xb_add(&ctl[CW_BGHEAD], 1u << 20); *slot = last; }
    __syncthreads();
    if (*slot) return;
    for (;;) {
        __syncthreads();
        if (c.tid == 0) *slot = xb_add(&ctl[CW_BGHEAD], 1u);
        __syncthreads();
        const unsigned raw = *slot, item = raw & 0xFFFFFu;
        if (item >= (unsigned)CONV_ITEMS) break;
#pragma unroll 1
        for (int q = 0; q < CONV_PER; ++q) conv_tile(c, (int)item * CONV_PER + q);
        if ((int)(raw >> 20) > phase) break;
    }
}
DI void bg_drain(const Ctx& c) { bg_run(c, -1); }

struct EpiStoreBf16 {
    static constexpr int STAGED = 1;
    bf16_t* O; int ld, nrows; float* ssq; bf16_t* U2;
    DI void chunk(int m, int n, const f32x4& v, int) const {
        if (m < nrows) { u32x2 o; o.x = pk2(v.x, v.y); o.y = pk2(v.z, v.w);
            if (U2 != nullptr && n >= 512) {
                int u, j; if (m < MLAT) { const int t = m & 4095; u = (m >> 12) * NUNIT_B + 16 + (t >> 4); j = t & 15; } else { const int tt = (m - MLAT) & 255; u = ((m - MLAT) >> 8) * NUNIT_B + (tt >> 4); j = tt & 15; }
                const int g = (n - 512) >> 4, ch = (n - 512) & 15;
                *(u32x2*)(U2 + (((size_t)u * 32 + g) * 16 + j) * 16 + ch) = o;
            } else *(u32x2*)(O + (size_t)m * ld + n) = o; }
        if (ssq != nullptr && n < 384) {
            float sq = (v.x * v.x + v.y * v.y) + (v.z * v.z + v.w * v.w);
            sq += dpp_f<0xB1>(sq); sq += dpp_f<0x4E>(sq); sq += dpp_f<0x141>(sq); sq += dpp_f<0x140>(sq);
            if ((n & 63) == 0 && m < nrows) ssq[(size_t)m * 8 + (n >> 6)] = sq;
        }
    }
};
template <int PROBE> DI void inproj_tile(const Ctx& c, int mt, int nt) {
    RowLoader<4> al; al.base = c.ws<bf16_t>(WS_XM); al.ld = 1024; al.nrows = MALL;
    RowLoader<2> wl; wl.base = c.ws<bf16_t>(WS_WTIN); wl.ld = 1024; wl.nrows = 1024;
    EpiStoreBf16 epi{c.ws<bf16_t>(WS_P), 512, MALL, c.ws<float>(WS_SSQP), c.ws<bf16_t>(WS_U2)};
    gemm_tile<PROBE>(c, al, wl, mt * 256, nt * 128, 1024, epi, nullptr, -1);
}
template <int PROBE = 0> DI void stage_inproj(const Ctx& c) {
    const int ntile = 68 * 8;
    for (int it = c.vb; it < ntile; it += c.G) inproj_tile<PROBE>(c, it >> 3, it & 7);
    if (PROBE == 0) {
        const int nfree = c.G - (ntile % c.G), first = ntile % c.G;
        constexpr int NCH = 768 + PREP_LATE;
        const int c0 = (nfree >= c.G || ntile % c.G == 0) ? c.vb : c.vb - first, cs = (nfree >= c.G || ntile % c.G == 0) ? c.G : nfree;
        if (c0 >= 0) for (int ch = c0; ch < NCH; ch += cs) { if (ch < 256) m16_chunk(c, ch); else if (ch < 768) w3_chunk(c, ch - 256); else prep_item(c, prep_late_index(ch - 768)); }
    }
}

struct EpiQ {
    static constexpr int STAGED = 2;
    bf16_t* Q; const LAS float* rs; const float* ropec; const float* ropes;
    DI void staged(const LAS float* reg, int lane, int mw, int nw, int lrow0) const {
        const int rr = lane >> 4, cc = (lane & 15) * 4;
        const int n = nw + cc, head = n / 96, d = n % 96;
#pragma unroll 8
        for (int j = 0; j < 16; ++j) {
            const int row = 4 * j + rr, m = mw + row, b = m >> 12, t = m & 4095; const float rq = rs[lrow0 + row] * QSCALE;
            const f32x4 v = *(const LAS f32x4*)(reg + row * 68 + cc);
            bf16_t* q = Q + ((size_t)(b * NH + head) * SEQ + t) * 96 + d;
            f32x4 o;
            if (d < 64) o = v * rq;
            else { const int i = (d - 64) & 15; const bool lo = d < 80;
                const f32x4 pv = *(const LAS f32x4*)(reg + row * 68 + (lo ? cc + 16 : cc - 16));
                const f32x4 cs = *(const f32x4*)(ropec + t * 16 + i), sn = *(const f32x4*)(ropes + t * 16 + i);
                o = lo ? (v * cs - pv * sn) * rq : (v * cs + pv * sn) * rq; }
            u32x2 w; w.x = pk2(o.x, o.y); w.y = pk2(o.z, o.w); *(u32x2*)q = w;
        }
    }
};
struct EpiKV {
    static constexpr int STAGED = 1;
    unsigned char* wsb; const LAS float* rs;
    DI void chunk(int m, int n, const f32x4& v, int lrow) const {
        if (m >= MALL) return;
        int b, key; if (m < MLAT) { b = m >> 12; key = m & 4095; } else { b = (m - MLAT) >> 8; key = SEQ + ((m - MLAT) & 255); }
        const float rk = rs[lrow]; const int head = n >> 7, db = n & 127;
        bf16_t* dst = (bf16_t*)(wsb + (db < 64 ? WS_K : WS_VT)) + ((size_t)(b * NH + head) * NKEY + key) * 64 + (db & 63);
        u32x2 o; o.x = pk2(v.x * rk, v.y * rk); o.y = pk2(v.z * rk, v.w * rk); *(u32x2*)dst = o;
    }
};
struct UcLoader {
    const bf16_t* U2; int g; const bf16_t* rp[4];
    DI void init(int i, int u) { rp[i] = U2 + ((size_t)(u < NUNIT ? u : NUNIT - 1) * 32 + g) * 256; }
    DI const bf16_t* ptr(int i, int k) const { return rp[i] + k; }
};
struct EpiST {
    static constexpr int STAGED = 0;
    bf16_t* ST; int g;
    DI void run(const f32x16 (&acc)[2][2], int mbase, int nb0, int h, int) const {
#pragma unroll
        for (int im = 0; im < 2; ++im) { const int u = mbase + im * 32; if (u >= NUNIT) continue;
#pragma unroll
            for (int in = 0; in < 2; ++in)
#pragma unroll
                for (int gq = 0; gq < 4; gq += 2) { const int n = nb0 + in * 32 + 8 * gq + 8 * h; const f32x16& v = acc[in][im];
                    u32x2 a, b; a.x = pk2(v[4 * gq], v[4 * gq + 1]); a.y = pk2(v[4 * gq + 2], v[4 * gq + 3]); b.x = pk2(v[4 * gq + 4], v[4 * gq + 5]); b.y = pk2(v[4 * gq + 6], v[4 * gq + 7]);
                    *(u32x4*)(ST + ((size_t)u * 32 + g) * 256 + n) = widen_pair(a, b); } }
    }
};
template <int MASK = 7> DI void stage_upproj(const Ctx& c) {
    constexpr int N_Q = 64 * 6, N_KV = 68 * 8, N_S1 = 32 * 5 * 2;
    LAS float* rs = (LAS float*)(c.lds + G_SCR);
    const bf16_t* P = c.ws<bf16_t>(WS_P);
    for (int it0 = c.vb; it0 < N_Q + N_KV + N_S1; it0 += c.G) {
        int it = it0;
        __syncthreads();
        if (it < N_Q) {
            if (!(MASK & 1)) continue;
            const int mt = it / 6, nt = it % 6;
            if (c.tid < 256) { const f32x4 s4 = *(const f32x4*)(c.ws<float>(WS_SSQP) + (size_t)(mt * 256 + c.tid) * 8); rs[c.tid] = rsqrtf(((s4.x + s4.y) + (s4.z + s4.w)) * (1.f / 256.f) + EPS); }
            __syncthreads();
            RowLoader<4> al; al.base = P; al.ld = 512; al.nrows = MLAT;
            RowLoader<2> wl; wl.base = c.ws<bf16_t>(WS_WTUQ); wl.ld = 256; wl.nrows = 768;
            EpiQ epi{c.ws<bf16_t>(WS_Q), rs, c.ws<float>(WS_ROPEC), c.ws<float>(WS_ROPES)};
            gemm_tile<(MASK & 8) ? 4 : 0>(c, al, wl, mt * 256, nt * 128, 256, epi, nullptr, -1);
            continue;
        }
        it -= N_Q;
        if (it < N_KV) {
            if (!(MASK & 2)) continue;
            const int mt = it / 8, nt = it % 8;
            if (c.tid < 256) { const f32x2 s2 = *(const f32x2*)(c.ws<float>(WS_SSQP) + (size_t)(mt * 256 + c.tid) * 8 + 4); rs[c.tid] = rsqrtf((s2.x + s2.y) * (1.f / 128.f) + EPS); }
            if (nt == 0) {
                bf16_t* KR = c.ws<bf16_t>(WS_KR);
                for (int idx = c.tid; idx < 256 * 16; idx += NT) {
                    const int row = idx >> 4, i = idx & 15, m = mt * 256 + row;
                    const float t1 = bf2f(P[(size_t)m * 512 + 384 + i]), t2 = bf2f(P[(size_t)m * 512 + 400 + i]);
                    float o1 = t1, o2 = t2; int b, key;
                    if (m < MLAT) { b = m >> 12; key = m & 4095; const float cs = c.ws<float>(WS_ROPEC)[key * 16 + i], sn = c.ws<float>(WS_ROPES)[key * 16 + i]; o1 = t1 * cs - t2 * sn; o2 = t2 * cs + t1 * sn; }
                    else { b = (m - MLAT) >> 8; key = SEQ + ((m - MLAT) & 255); }
                    bf16_t* kp = KR + ((size_t)b * NKEY + key) * 32; kp[i] = f2bf(o1); kp[16 + i] = f2bf(o2);
                }
            }
            __syncthreads();
            RowLoader<4> al; al.base = P + 256; al.ld = 512; al.nrows = MALL;
            RowLoader<2> wl; wl.base = c.ws<bf16_t>(WS_WTUKV); wl.ld = 128; wl.nrows = 1024;
            EpiKV epi{c.p.ws, rs};
            gemm_tile<(MASK & 8) ? 4 : 0>(c, al, wl, mt * 256, nt * 128, 128, epi, nullptr, -1);
            continue;
        }
        it -= N_KV;
        if (MASK & 4) {
            const int g = it / 10, mt = (it % 10) >> 1, nt = it & 1;
            UcLoader al; al.U2 = c.ws<bf16_t>(WS_U2); al.g = g;
            RowLoader<2> wl; wl.base = c.ws<bf16_t>(WS_M16) + (size_t)g * 256 * 256; wl.ld = 256; wl.nrows = 256;
            EpiST epi{c.ws<bf16_t>(WS_ST), g};
            gemm_tile(c, al, wl, mt * 256, nt * 128, 256, epi, nullptr, -1);
        }
    }
}

DI void stage_carry(const Ctx& c) {
    LAS f32x2* segend = (LAS f32x2*)c.lds;
    const int p = c.tid & 63, seg = c.wid;
    for (int it = c.bid; it < NB * 32 * 2; it += c.G) {
        const int d = it & 1, g = (it >> 1) & 31, b = it >> 6;
        const float2 a16 = c.ws<float2>(WS_PW)[(size_t)((d * 32 + g) * 64 + p) * 20 + 16];
        unsigned* st = (unsigned*)(c.ws<bf16_t>(WS_ST) + ((size_t)(b * NUNIT_B) * 32 + g) * 256 + d * 128) + p;
        float vr[34], vi[34];
#pragma unroll
        for (int q = 0; q < 34; ++q) { const int s = seg * 34 + q; const int ci = d == 0 ? s : (s < 16 ? 15 - s : (NUNIT_B - 1) - (s - 16)); const unsigned u = st[(size_t)ci * 4096]; vr[q] = lo16(u); vi[q] = hi16(u); }
        float er = 0.f, ei = 0.f;
#pragma unroll
        for (int q = 0; q < 34; ++q) { const float xr = vr[q], xi = vi[q]; vr[q] = er; vi[q] = ei; const float nr = a16.x * er - a16.y * ei + xr, ni = a16.x * ei + a16.y * er + xi; er = nr; ei = ni; }
        __syncthreads();
        segend[seg * 64 + p] = (f32x2){er, ei};
        float2 a2 = make_float2(a16.x * a16.x - a16.y * a16.y, 2.f * a16.x * a16.y), t = a2;
#pragma unroll
        for (int i = 0; i < 4; ++i) t = make_float2(t.x * t.x - t.y * t.y, 2.f * t.x * t.y);
        const float2 a34 = make_float2(t.x * a2.x - t.y * a2.y, t.x * a2.y + t.y * a2.x);
        __syncthreads();
        float cr = 0.f, ci_ = 0.f;
        for (int j = 0; j < seg; ++j) { const f32x2 e = segend[j * 64 + p]; const float nr = a34.x * cr - a34.y * ci_ + e.x, ni = a34.x * ci_ + a34.y * cr + e.y; cr = nr; ci_ = ni; }
#pragma unroll
        for (int q = 0; q < 34; ++q) { const int s = seg * 34 + q; const int ci = d == 0 ? s : (s < 16 ? 15 - s : (NUNIT_B - 1) - (s - 16));
            __hip_atomic_store(st + (size_t)ci * 4096, pk2(vr[q] + cr, vi[q] + ci_), __ATOMIC_RELAXED, __HIP_MEMORY_SCOPE_AGENT);
            const float nr = a16.x * cr - a16.y * ci_, ni = a16.x * ci_ + a16.y * cr; cr = nr; ci_ = ni; }
        publish_wt(c, c.ws<unsigned>(WS_CTL) + CW_CARRYC);
    }
}

struct SsmALoader {
    const bf16_t* U2; const bf16_t* ST; int g; const bf16_t* sp[4]; const bf16_t* up[4];
    DI void init(int i, int u) { const int uu = (u >> 8) * NUNIT_B + 16 + (u & 255); sp[i] = ST + ((size_t)uu * 32 + g) * 256; up[i] = U2 + ((size_t)uu * 32 + g) * 256; }
    DI const bf16_t* ptr(int i, int k) const { return k < 256 ? sp[i] + k : up[i] + (k - 256); }
};
struct EpiG {
    static constexpr int STAGED = 0;
    bf16_t* Gb; int g;
    DI void run(const f32x16 (&acc)[2][2], int mbase, int nb0, int h, int) const {
#pragma unroll
        for (int im = 0; im < 2; ++im) { const int u = mbase + im * 32;
            const int row0 = (u >> 8) * SEQ + 16 * (u & 255);
#pragma unroll
            for (int in = 0; in < 2; ++in)
#pragma unroll
                for (int gq = 0; gq < 4; gq += 2) { const int n = nb0 + in * 32 + 8 * gq + 8 * h, i = n >> 4, hh = n & 15; const f32x16& v = acc[in][im];
                    u32x2 a, b; a.x = pk2(geluf_(v[4 * gq]), geluf_(v[4 * gq + 1])); a.y = pk2(geluf_(v[4 * gq + 2]), geluf_(v[4 * gq + 3]));
                    b.x = pk2(geluf_(v[4 * gq + 4]), geluf_(v[4 * gq + 5])); b.y = pk2(geluf_(v[4 * gq + 6]), geluf_(v[4 * gq + 7]));
                    store16_wt(Gb + (size_t)(row0 + i) * 512 + 16 * g + hh, widen_pair(a, b)); } }
    }
};
DI void stage_ssmout(const Ctx& c) {
    if (c.vb < 256) wait_acquire(c, c.ws<unsigned>(WS_CTL) + CW_CARRYC, NB * 32 * 2);
    for (int it = c.vb; it < 256; it += c.G) {
        const int g = it >> 3, mt = (it >> 1) & 3, nt = it & 1;
        SsmALoader al; al.U2 = c.ws<bf16_t>(WS_U2); al.ST = c.ws<bf16_t>(WS_ST); al.g = g;
        RowLoader<2> wl; wl.base = c.ws<bf16_t>(WS_W3) + (size_t)g * 256 * 512; wl.ld = 512; wl.nrows = 256;
        EpiG epi{c.ws<bf16_t>(WS_G), g};
        gemm_tile(c, al, wl, mt * 256, nt * 128, 512, epi, nullptr, -1);
        publish_wt(c, c.ws<unsigned>(WS_CTL) + CW_SSMC);
    }
}

struct EpiGLU {
    static constexpr int STAGED = 0;
    const bf16_t* Gb; bf16_t* Mix; const float* bias; float* ssq;
    DI void run(const f32x16 (&acc)[2][2], int mbase, int nb0, int h, int) const {
#pragma unroll
        for (int im = 0; im < 2; ++im) { const int m = mbase + im * 32; float sq = 0.f;
#pragma unroll
            for (int in = 0; in < 2; ++in)
#pragma unroll
                for (int gp = 0; gp < 4; gp += 2) { u32x2 ob[2];
#pragma unroll
                    for (int q = 0; q < 2; ++q) { const int g = gp + q; const int n = nb0 + in * 32 + 8 * g + 4 * h; const f32x16& v = acc[in][im];
                        const u32x2 gg = *(const u32x2*)(Gb + (size_t)m * 512 + n); const f32x4 bb = *(const f32x4*)(bias + n);
                        const float g0 = lo16(gg.x), g1 = hi16(gg.x), g2 = lo16(gg.y), g3 = hi16(gg.y);
                        const float o0 = g0 * sigmoidf_(v[4 * g] + bb.x), o1 = g1 * sigmoidf_(v[4 * g + 1] + bb.y), o2 = g2 * sigmoidf_(v[4 * g + 2] + bb.z), o3 = g3 * sigmoidf_(v[4 * g + 3] + bb.w);
                        sq += (o0 * o0 + o1 * o1) + (o2 * o2 + o3 * o3);
                        ob[q].x = pk2(o0, o1); ob[q].y = pk2(o2, o3); }
                    *(u32x4*)(Mix + (size_t)m * 1024 + 512 + nb0 + in * 32 + 8 * gp + 8 * h) = widen_pair(ob[0], ob[1]); }
            sq += __shfl_xor(sq, 32);
            if (h == 0) ssq[(size_t)m * 8 + (nb0 >> 6)] = sq; }
    }
};
DI void stage_glu(const Ctx& c) {
    if (c.vb < 64 * 4) wait_acquire(c, c.ws<unsigned>(WS_CTL) + CW_SSMC, 256);
    for (int it = c.vb; it < 64 * 4; it += c.G) {
        const int mt = it >> 2, nt = it & 3;
        RowLoader<4> al; al.base = c.ws<bf16_t>(WS_G); al.ld = 512; al.nrows = MLAT;
        RowLoader<2> wl; wl.base = c.ws<bf16_t>(WS_WTGLU); wl.ld = 512; wl.nrows = 512;
        EpiGLU epi{c.ws<bf16_t>(WS_G), c.ws<bf16_t>(WS_MIX), c.in(I_BGLU), c.ws<float>(WS_SSQS)};
        gemm_tile(c, al, wl, mt * 256, nt * 128, 512, epi, nullptr, -1);
    }
    bg_drain(c);
}

constexpr int AT_KROW = 208, AT_VROW = 192, AT_KBYTES = 64 * AT_KROW, AT_VBYTES = 64 * AT_VROW, AT_VOFF = 3 * AT_KBYTES;
constexpr float AT_THR = 8.f;
typedef short s16x4 __attribute__((ext_vector_type(4)));
DI bf16x8 tr_frag(const LAS unsigned char* p) {
    const s16x4 lo = __builtin_amdgcn_ds_read_tr16_b64_v4i16((LAS s16x4*)p), hi = __builtin_amdgcn_ds_read_tr16_b64_v4i16((LAS s16x4*)(p + 8 * AT_VROW));
    return __builtin_shufflevector(lo, hi, 0, 1, 2, 3, 4, 5, 6, 7);
}
DI void stage_attn(const Ctx& c, int ufirst, int ulast) {
    const int lane = c.lane, wid = c.wid, r = lane & 31, h = lane >> 5, tid = c.tid;
    const bf16_t* Qb = c.ws<bf16_t>(WS_Q); const bf16_t* Kb = c.ws<bf16_t>(WS_K); const bf16_t* Vt = c.ws<bf16_t>(WS_VT);
    bf16_t* Mix = c.ws<bf16_t>(WS_MIX);
    constexpr int NTILE = NKEY / 64;
    for (int unit = ufirst + c.vb; unit < ulast; unit += c.G) {
        const int qb = unit & 15, bh = unit >> 4, b = bh >> 3, hd = bh & 7;
        const int q0 = qb * 256 + wid * 32;
        bf16x8 qf[6];
        { const bf16_t* qp = Qb + ((size_t)bh * SEQ + q0 + r) * 96 + 8 * h;
#pragma unroll
          for (int ks = 0; ks < 6; ++ks) qf[ks] = *(const bf16x8*)(qp + ks * 16); }
        const int kq0 = tid, kq1 = tid + 512, vr = tid >> 3, vc = tid & 7;
        const int klo0 = (kq0 / 12) * AT_KROW + (kq0 % 12) * 16, klo1 = (kq1 / 12) * AT_KROW + (kq1 % 12) * 16, vlo = vr * AT_VROW + vc * 16;
        const unsigned char* wsb = c.p.ws;
        const int kc0 = kq0 % 12, kc1 = kq1 % 12;
        const unsigned knb = (unsigned)WS_K + (unsigned)bh * NKEY * 128u, krb = (unsigned)WS_KR + (unsigned)b * NKEY * 64u;
        unsigned ko0 = kc0 < 8 ? knb + (kq0 / 12) * 128u + kc0 * 16u : krb + (kq0 / 12) * 64u + (kc0 - 8) * 16u; const unsigned kst0 = kc0 < 8 ? 64u * 128u : 64u * 64u;
        unsigned ko1 = kc1 < 8 ? knb + (kq1 / 12) * 128u + kc1 * 16u : krb + (kq1 / 12) * 64u + (kc1 - 8) * 16u; const unsigned kst1 = kc1 < 8 ? 64u * 128u : 64u * 64u;
        unsigned vo = (unsigned)WS_VT + (unsigned)bh * NKEY * 128u + (unsigned)tid * 16u;
        u32x4 rk0, rk1 = (u32x4){0u, 0u, 0u, 0u}, rv;
        f32x16 o[2]; float mrun = 0.f, lrun = 0.f;
#pragma unroll
        for (int i = 0; i < 2; ++i)
#pragma unroll
            for (int e = 0; e < 16; ++e) o[i][e] = 0.f;
        __syncthreads();
        rk0 = *(const u32x4*)(wsb + ko0); if (tid < 256) rk1 = *(const u32x4*)(wsb + ko1);
        rv = *(const u32x4*)(wsb + vo);
        *(LAS u32x4*)(c.lds + klo0) = rk0; if (tid < 256) *(LAS u32x4*)(c.lds + klo1) = rk1;
        *(LAS u32x4*)(c.lds + AT_VOFF + vlo) = rv;
        ko0 += kst0; ko1 += kst1; vo += 8192u;
        rk0 = *(const u32x4*)(wsb + ko0); if (tid < 256) rk1 = *(const u32x4*)(wsb + ko1);
        *(LAS u32x4*)(c.lds + AT_KBYTES + klo0) = rk0; if (tid < 256) *(LAS u32x4*)(c.lds + AT_KBYTES + klo1) = rk1;
        ko0 += kst0; ko1 += kst1;
        __syncthreads();
        f32x16 sa[2], sb[2];
        {
            const LAS unsigned char* sk = c.lds + r * AT_KROW + h * 16;
#pragma unroll
            for (int kt2 = 0; kt2 < 2; ++kt2) {
#pragma unroll
                for (int e = 0; e < 16; ++e) sa[kt2][e] = 0.f;
#pragma unroll
                for (int ks = 0; ks < 6; ++ks) { const bf16x8 kf = *(const LAS bf16x8*)(sk + kt2 * 32 * AT_KROW + ks * 32); sa[kt2] = MFMA32(kf, qf[ks], sa[kt2]); }
            }
        }
        int ks1 = 1, ks2 = 2, vs0 = 0;
#define ATT_STEP(SA, SB, T, N1, N2)                                                                                                       \
        {                                                                                                                           \
            const int t_ = (T);                                                                                                     \
            if (N2) { rk0 = *(const u32x4*)(wsb + ko0); if (tid < 256) rk1 = *(const u32x4*)(wsb + ko1); ko0 += kst0; ko1 += kst1; }   \
            if (N1) { rv = *(const u32x4*)(wsb + vo); vo += 8192u; }                                                  \
            float mx = SA[0][0];                                                                                                    \
            _Pragma("unroll") for (int e = 1; e < 16; ++e) mx = fmaxf(mx, SA[0][e]);                                               \
            _Pragma("unroll") for (int e = 0; e < 16; ++e) mx = fmaxf(mx, SA[1][e]);                                               \
            mx = fmaxf(mx, __shfl_xor(mx, 32));                                                                                     \
            if (t_ == 0 || __any(mx > AT_THR)) {                                                                                    \
                const float delta = t_ == 0 ? mx : fmaxf(mx, 0.f), alpha = __builtin_amdgcn_exp2f(-delta);                          \
                mrun += delta; lrun *= alpha;                                                                                       \
                _Pragma("unroll") for (int e = 0; e < 16; ++e) { o[0][e] *= alpha; o[1][e] *= alpha; SA[0][e] -= delta; SA[1][e] -= delta; } \
            }                                                                                                                       \
            __builtin_amdgcn_s_setprio(1);                                                                                          \
            if (N1) {                                                                                                               \
                const LAS unsigned char* sk = c.lds + ks1 * AT_KBYTES + r * AT_KROW + h * 16; const float nm = -mrun;               \
                _Pragma("unroll") for (int kt2 = 0; kt2 < 2; ++kt2) {                                                               \
                    _Pragma("unroll") for (int e = 0; e < 16; ++e) SB[kt2][e] = nm;                                                 \
                    _Pragma("unroll") for (int ks = 0; ks < 6; ++ks) { const bf16x8 kf = *(const LAS bf16x8*)(sk + kt2 * 32 * AT_KROW + ks * 32); SB[kt2] = MFMA32(kf, qf[ks], SB[kt2]); } \
                }                                                                                                                   \
            }                                                                                                                       \
            float ps = 0.f;                                                                                                         \
            _Pragma("unroll") for (int kt2 = 0; kt2 < 2; ++kt2)                                                                     \
                _Pragma("unroll") for (int e = 0; e < 16; ++e) { const float pv = __builtin_amdgcn_exp2f(SA[kt2][e]); SA[kt2][e] = pv; ps += pv; } \
            lrun += ps;                                                                                                             \
            const LAS unsigned char* sv = c.lds + AT_VOFF + vs0 * AT_VBYTES + (4 * h + ((lane & 15) >> 2)) * AT_VROW + (16 * ((lane >> 4) & 1) + 4 * (lane & 3)) * 2; \
            _Pragma("unroll") for (int kt2 = 0; kt2 < 2; ++kt2)                                                                     \
                _Pragma("unroll") for (int s = 0; s < 2; ++s) {                                                                     \
                    u32x4 pp; pp.x = pk2(SA[kt2][8 * s], SA[kt2][8 * s + 1]); pp.y = pk2(SA[kt2][8 * s + 2], SA[kt2][8 * s + 3]);   \
                    pp.z = pk2(SA[kt2][8 * s + 4], SA[kt2][8 * s + 5]); pp.w = pk2(SA[kt2][8 * s + 6], SA[kt2][8 * s + 7]);         \
                    const bf16x8 pb = __builtin_bit_cast(bf16x8, pp);                                                               \
                    _Pragma("unroll") for (int dt = 0; dt < 2; ++dt) { const bf16x8 vf = tr_frag(sv + (kt2 * 32 + s * 16) * AT_VROW + dt * 64); o[dt] = MFMA32(vf, pb, o[dt]); } \
                }                                                                                                                   \
            if (N1) {                                                      \
                __builtin_amdgcn_sched_group_barrier(0x100, 3, 0);                                                                  \
                _Pragma("unroll") for (int i_ = 0; i_ < 9; ++i_) { __builtin_amdgcn_sched_group_barrier(0x008, 1, 0); __builtin_amdgcn_sched_group_barrier(0x100, 1, 0); __builtin_amdgcn_sched_group_barrier(0x400, 3, 0); } \
                _Pragma("unroll") for (int i_ = 0; i_ < 3; ++i_) { __builtin_amdgcn_sched_group_barrier(0x008, 1, 0); __builtin_amdgcn_sched_group_barrier(0x400, 2, 0); } \
                __builtin_amdgcn_sched_group_barrier(0x100, 4, 0);         \
                _Pragma("unroll") for (int i_ = 0; i_ < 6; ++i_) { __builtin_amdgcn_sched_group_barrier(0x008, 1, 0); __builtin_amdgcn_sched_group_barrier(0x100, 2, 0); } \
                _Pragma("unroll") for (int i_ = 0; i_ < 2; ++i_) { __builtin_amdgcn_sched_group_barrier(0x008, 1, 0); }             \
            }                                                                                                                       \
            __builtin_amdgcn_s_setprio(0);                                                                                          \
            if (N2) { LAS unsigned char* sb_ = c.lds + ks2 * AT_KBYTES; *(LAS u32x4*)(sb_ + klo0) = rk0; if (tid < 256) *(LAS u32x4*)(sb_ + klo1) = rk1; } \
            if (N1) *(LAS u32x4*)(c.lds + AT_VOFF + (vs0 ^ 1) * AT_VBYTES + vlo) = rv;                                  \
            __syncthreads();                                                                                                        \
            ks1 = ks1 == 2 ? 0 : ks1 + 1; ks2 = ks2 == 2 ? 0 : ks2 + 1; vs0 ^= 1;                                                   \
        }
        for (int t = 0; t < NTILE - 2; t += 2) {
            ATT_STEP(sa, sb, t, true, true)
            ATT_STEP(sb, sa, t + 1, true, true)
        }
        ATT_STEP(sa, sb, NTILE - 2, true, false)
        ATT_STEP(sb, sa, NTILE - 1, false, false)
#undef ATT_STEP
        const float linv = 1.f / (lrun + __shfl_xor(lrun, 32));
        { float sq = 0.f;
#pragma unroll
          for (int dt = 0; dt < 2; ++dt)
#pragma unroll
              for (int e = 0; e < 16; ++e) { const float v = o[dt][e] * linv; sq += v * v; }
          sq += __shfl_xor(sq, 32);
          if (h == 0) c.ws<float>(WS_SSQA)[(size_t)(b * SEQ + q0 + r) * 8 + hd] = sq; }
        bf16_t* op = Mix + (size_t)(b * SEQ + q0 + r) * 1024 + hd * 64;
#pragma unroll
        for (int dt = 0; dt < 2; ++dt)
#pragma unroll
            for (int g = 0; g < 4; g += 2) { u32x2 wa, wb; wa.x = pk2(o[dt][4 * g] * linv, o[dt][4 * g + 1] * linv); wa.y = pk2(o[dt][4 * g + 2] * linv, o[dt][4 * g + 3] * linv);
                wb.x = pk2(o[dt][4 * g + 4] * linv, o[dt][4 * g + 5] * linv); wb.y = pk2(o[dt][4 * g + 6] * linv, o[dt][4 * g + 7] * linv);
                *(u32x4*)(op + dt * 32 + 8 * g + 8 * h) = widen_pair(wa, wb); }
    }
}

struct EpiWo {
    static constexpr int STAGED = 1;
    const float* x; bf16_t* y1; const float* mod; const LAS float* rssm;
    DI void chunk(int m, int n, const f32x4& v, int lrow) const {
        const int b = m >> 12; const float rs = rssm[lrow];
        const f32x4 xv = __builtin_nontemporal_load((const f32x4*)(x + (size_t)m * 1024 + n)), gv = *(const f32x4*)(mod + (size_t)b * 6144 + 2048 + n);
        const f32x4 y = ALPHA * xv + gv * (v * rs);
        u32x2 o; o.x = pk2(y.x, y.y); o.y = pk2(y.z, y.w);
        __hip_atomic_store((unsigned long long*)(y1 + (size_t)m * 1024 + n), (unsigned long long)o.x | ((unsigned long long)o.y << 32), __ATOMIC_RELAXED, __HIP_MEMORY_SCOPE_AGENT);
    }
};
DI void stage_wo(const Ctx& c) {
    LAS float* ratio = (LAS float*)(c.lds + G_SCR);
    LAS float* rssm = ratio + 256;
    const bf16_t* Mix = c.ws<bf16_t>(WS_MIX);
    for (int it = c.vb; it < 64 * 4; it += c.G) {
        const int mt = it >> 2, nt = it & 3;
        __syncthreads();
        if (c.tid < 256) { const int row = mt * 256 + c.tid;
          const f32x4 a0 = *(const f32x4*)(c.ws<float>(WS_SSQA) + (size_t)row * 8), a1 = *(const f32x4*)(c.ws<float>(WS_SSQA) + (size_t)row * 8 + 4);
          const f32x4 s0 = *(const f32x4*)(c.ws<float>(WS_SSQS) + (size_t)row * 8), s1 = *(const f32x4*)(c.ws<float>(WS_SSQS) + (size_t)row * 8 + 4);
          const float sa = ((a0.x + a0.y) + (a0.z + a0.w)) + ((a1.x + a1.y) + (a1.z + a1.w)), ss = ((s0.x + s0.y) + (s0.z + s0.w)) + ((s1.x + s1.y) + (s1.z + s1.w));
          const float ra = rsqrtf(sa * (1.f / 512.f) + EPS), rs = rsqrtf(ss * (1.f / 512.f) + EPS);
          ratio[c.tid] = ra / rs; rssm[c.tid] = rs; }
        __syncthreads();
        EpiWo epi{c.in(I_X), c.ws<bf16_t>(WS_Y1B), c.ws<float>(WS_MOD), rssm};
        gemm_tile256(c, Mix, 1024, c.ws<bf16_t>(WS_WTO), 1024, mt * 256, nt * 256, 1024, epi, ratio, 15);
        publish_wt(c, c.ws<unsigned>(WS_CTL) + CW_WOC + 16 * mt);
    }
}

DI void stage_ln1(const Ctx& c) {
    const float* mod = c.ws<float>(WS_MOD);
    unsigned* ctl = c.ws<unsigned>(WS_CTL);
    constexpr int HROW = 2064;
    constexpr int PSTR = 36;
    LAS unsigned char* hh = c.lds; LAS unsigned char* hl = c.lds + 32 * HROW;
    LAS float* P = (LAS float*)c.lds;
    LAS float* GL = (LAS float*)(c.lds + 64 * HROW);
    LAS float* RB = GL + 128;
    LAS unsigned* lcnt = (LAS unsigned*)(c.lds + 140032);
    LAS unsigned* lbase = lcnt + 32;
    LAS unsigned* dec = lcnt + 64;
    const bf16_t* WrH = c.ws<bf16_t>(WS_WRH); const bf16_t* WrL = c.ws<bf16_t>(WS_WRL);
    const bf16_t* Y1 = c.ws<bf16_t>(WS_Y1B); bf16_t* Hp = c.ws<bf16_t>(WS_H);
    const int r = c.lane & 31, h = c.lane >> 5;
    __syncthreads();
    if (c.tid < 36) RB[c.tid] = c.tid < 4 ? c.in(I_BRG)[c.tid] : c.in(I_BRE2)[c.tid - 4];
    for (int rb = c.vb; rb < MLAT / 64; rb += c.G) {
        const int b = (rb * 64) >> 12;
        wait_acquire(c, ctl + CW_WOC + 16 * (rb >> 2), 4u);
        u32x2 raw[4][4];
#pragma unroll
        for (int rr = 0; rr < 4; ++rr)
#pragma unroll
            for (int j = 0; j < 4; ++j) raw[rr][j] = __builtin_nontemporal_load((const u32x2*)(Y1 + (((rb * 64 + c.wid * 4) * 1024 + c.lane * 4) + (rr * 1024 + j * 256))));
        __syncthreads();
        if (c.tid < 32) lcnt[c.tid] = 0u;
#pragma unroll 1
        for (int half = 0; half < 2; ++half) {
            int rowb = rb * 64 + half * 32; asm volatile("" : "+s"(rowb));
            __syncthreads();
            {
                float mean[4], rstd[4];
#pragma unroll
                for (int rr = 0; rr < 4; ++rr) {
                    float s = 0.f;
#pragma unroll
                    for (int j = 0; j < 4; ++j) s += (lo16(raw[rr][j].x) + hi16(raw[rr][j].x)) + (lo16(raw[rr][j].y) + hi16(raw[rr][j].y));
                    mean[rr] = wave_sum_fast(s) * (1.f / 1024.f);
                    float q = 0.f;
#pragma unroll
                    for (int j = 0; j < 4; ++j) { const float d0 = lo16(raw[rr][j].x) - mean[rr], d1 = hi16(raw[rr][j].x) - mean[rr], d2 = lo16(raw[rr][j].y) - mean[rr], d3 = hi16(raw[rr][j].y) - mean[rr];
                        q += (d0 * d0 + d1 * d1) + (d2 * d2 + d3 * d3); }
                    rstd[rr] = rsqrtf(wave_sum_fast(q) * (1.f / 1024.f) + EPS);
                    if (c.lane == 0) *(f32x2*)(c.ws<float>(WS_STATS) + (size_t)(rowb + c.wid * 4 + rr) * 2) = (f32x2){mean[rr], rstd[rr]};
                }
                f32x4 gd[4];
#pragma unroll
                for (int rr = 0; rr < 4; ++rr) gd[rr] = (f32x4){0.f, 0.f, 0.f, 0.f};
#pragma unroll
                for (int rr = 0; rr < 4; ++rr)
#pragma unroll
                    for (int j = 0; j < 4; ++j) asm volatile("" : "+v"(raw[rr][j]));
                const float* lgp = c.in(I_LN1G); const float* lbp = c.in(I_LN1B); const float* mdp = mod + (size_t)b * 6144; const float* wgp = c.in(I_WRG);
                asm volatile("" : "+s"(lgp), "+s"(lbp), "+s"(mdp), "+s"(wgp));
#pragma unroll
                for (int j = 0; j < 4; ++j) {
                    const unsigned n = (unsigned)(c.lane * 4) + (unsigned)(256 * j);
                    const f32x4 lg = *(const f32x4*)(lgp + n), lb = *(const f32x4*)(lbp + n);
                    const f32x4 sh = *(const f32x4*)(mdp + 3072 + n), sc = *(const f32x4*)(mdp + 4096 + n) + 1.f;
                    const f32x4 w0 = *(const f32x4*)(wgp + n * 4), w1 = *(const f32x4*)(wgp + n * 4 + 4),
                                w2 = *(const f32x4*)(wgp + n * 4 + 8), w3 = *(const f32x4*)(wgp + n * 4 + 12);
#pragma unroll
                    for (int rr = 0; rr < 4; ++rr) {
                        const int lr = c.wid * 4 + rr;
                        const f32x4 x = (f32x4){lo16(raw[rr][j].x), hi16(raw[rr][j].x), lo16(raw[rr][j].y), hi16(raw[rr][j].y)};
                        const f32x4 hq = ((x - mean[rr]) * rstd[rr] * lg + lb) * sc + sh;
                        u32x2 o; o.x = pk2(hq.x, hq.y); o.y = pk2(hq.z, hq.w); *(u32x2*)(Hp + (((rowb + c.wid * 4) * 1024 + c.lane * 4) + (rr * 1024 + j * 256))) = o;
                        u32x2 l; l.x = pk2(hq.x - lo16(o.x), hq.y - hi16(o.x)); l.y = pk2(hq.z - lo16(o.y), hq.w - hi16(o.y));
                        *(LAS u32x2*)(hh + lr * HROW + n * 2) = o; *(LAS u32x2*)(hl + lr * HROW + n * 2) = l;
                        gd[rr] += hq.x * w0 + hq.y * w1 + hq.z * w2 + hq.w * w3;
                    }
                    __builtin_amdgcn_sched_barrier(0);
                }
#pragma unroll
                for (int rr = 0; rr < 4; ++rr) {
                    const float g0 = wave_sum_fast(gd[rr].x), g1 = wave_sum_fast(gd[rr].y), g2 = wave_sum_fast(gd[rr].z), g3 = wave_sum_fast(gd[rr].w);
                    if (c.lane == 0) *(LAS f32x4*)(GL + (c.wid * 4 + rr) * 4) = (f32x4){g0, g1, g2, g3};
                }
            }
            __builtin_amdgcn_sched_barrier(0);
            bf16x8 wf[8][2];
            const bf16_t* wrh = WrH; const bf16_t* wrl = WrL; asm volatile("" : "+s"(wrh), "+s"(wrl));
#pragma unroll
            for (int ks = 0; ks < 8; ++ks) { const unsigned o = (unsigned)((c.wid * 512 + c.lane) * 8) + (unsigned)(ks * 512); wf[ks][0] = *(const bf16x8*)(wrh + o); wf[ks][1] = *(const bf16x8*)(wrl + o); }
            if (half == 0) {
#pragma unroll
                for (int rr = 0; rr < 4; ++rr)
#pragma unroll
                    for (int j = 0; j < 4; ++j) raw[rr][j] = __builtin_nontemporal_load((const u32x2*)(Y1 + (((rowb + 32 + c.wid * 4) * 1024 + c.lane * 4) + (rr * 1024 + j * 256))));
            }
            __syncthreads();
            f32x16 acc;
#pragma unroll
            for (int e = 0; e < 16; ++e) acc[e] = 0.f;
#pragma unroll
            for (int ks = 0; ks < 8; ++ks) {
                const int k0 = c.wid * 128 + ks * 16 + 8 * h;
                const bf16x8 bh = *(const LAS bf16x8*)(hh + r * HROW + k0 * 2), bl = *(const LAS bf16x8*)(hl + r * HROW + k0 * 2);
                acc = MFMA32(wf[ks][0], bh, acc); acc = MFMA32(wf[ks][0], bl, acc); acc = MFMA32(wf[ks][1], bh, acc);
            }
            __syncthreads();
#pragma unroll
            for (int g = 0; g < 4; ++g) *(LAS f32x4*)(P + (c.wid * 32 + r) * PSTR + 8 * g + 4 * h) = (f32x4){acc[4 * g], acc[4 * g + 1], acc[4 * g + 2], acc[4 * g + 3]};
            __syncthreads();
            if (c.tid < 32) {
                const int row = rowb + c.tid;
                const f32x4 g4 = *(const LAS f32x4*)(GL + c.tid * 4) + *(const LAS f32x4*)RB;
                const float l[4] = {g4.x, g4.y, g4.z, g4.w};
                int gi = 0; float gm = l[0];
#pragma unroll
                for (int e = 1; e < 4; ++e) if (l[e] > gm) { gm = l[e]; gi = e; }
                float gs = 0.f;
#pragma unroll
                for (int e = 0; e < 4; ++e) gs += __expf(l[e] - gm);
                const float gw = 1.f / gs;
                f32x4 ea = *(const LAS f32x4*)(RB + 4 + gi * 8), eb = *(const LAS f32x4*)(RB + 8 + gi * 8);
#pragma unroll
                for (int w = 0; w < 8; ++w) { ea += *(const LAS f32x4*)(P + (w * 32 + c.tid) * PSTR + gi * 8); eb += *(const LAS f32x4*)(P + (w * 32 + c.tid) * PSTR + gi * 8 + 4); }
                const float el[8] = {ea.x, ea.y, ea.z, ea.w, eb.x, eb.y, eb.z, eb.w};
                int i1 = 0; float l1 = el[0];
#pragma unroll
                for (int j = 1; j < 8; ++j) if (el[j] > l1) { l1 = el[j]; i1 = j; }
                int i2 = -1; float l2 = -3.0e38f;
#pragma unroll
                for (int j = 0; j < 8; ++j) if (j != i1 && el[j] > l2) { l2 = el[j]; i2 = j; }
                const float ex = __expf(l2 - l1), w1 = gw / (1.f + ex), w2 = gw * ex / (1.f + ex);
                const int e1 = gi * 8 + i1, e2 = gi * 8 + i2;
                const int slot = half * 32 + c.tid;
                const unsigned r1 = atomicAdd((unsigned*)&lcnt[e1], 1u), r2 = atomicAdd((unsigned*)&lcnt[e2], 1u);
                dec[slot * 4 + 0] = (unsigned)e1 | (r1 << 8); dec[slot * 4 + 1] = (unsigned)e2 | (r2 << 8); dec[slot * 4 + 2] = (unsigned)row;
                float* tw = c.ws<float>(WS_TOKW); tw[row * 2] = w1; tw[row * 2 + 1] = w2;
            }
        }
        __syncthreads();
        if (c.tid < 32) { const unsigned n = lcnt[c.tid]; lbase[c.tid] = n ? atomicAdd(&ctl[CNT_IDX(c.tid)], n) : 0u; }
        __syncthreads();
        if (c.tid < 64) {
            const unsigned d0 = dec[c.tid * 4], d1 = dec[c.tid * 4 + 1], row = dec[c.tid * 4 + 2];
            int* list = c.ws<int>(WS_LIST);
            list[(d0 & 255u) * 16384 + lbase[d0 & 255u] + (d0 >> 8)] = (int)(row * 2);
            list[(d1 & 255u) * 16384 + lbase[d1 & 255u] + (d1 >> 8)] = (int)(row * 2 + 1);
        }
    }
}

struct GatherLoader {
    const bf16_t* src; const LAS int* lt; int m00, ld, shift; const bf16_t* rp[4];
    DI void init(int i, int m) { const int ts = lt[m - m00]; rp[i] = src + (size_t)(ts >> shift) * ld; }
    DI const bf16_t* ptr(int i, int k) const { return rp[i] + k; }
};
struct EpiZ {
    static constexpr int STAGED = 0;
    bf16_t* Z; const LAS int* lt; const float* tw; int cnt, m00;
    DI void run(const f32x16 (&acc)[2][2], int mbase, int nb0, int h, int) const {
#pragma unroll
        for (int im = 0; im < 2; ++im) { const int ml = mbase + im * 32; if (ml >= cnt) continue; const int ts = lt[ml - m00]; const float w = tw[ts];
            const int jb = (nb0 >> 6) * 32;
#pragma unroll
            for (int gp = 0; gp < 4; gp += 2) { const f32x16& a = acc[0][im]; const f32x16& u = acc[1][im]; u32x2 ob[2];
#pragma unroll
                for (int q = 0; q < 2; ++q) { const int g = gp + q;
                    ob[q].x = pk2(siluf_(a[4 * g]) * u[4 * g] * w, siluf_(a[4 * g + 1]) * u[4 * g + 1] * w); ob[q].y = pk2(siluf_(a[4 * g + 2]) * u[4 * g + 2] * w, siluf_(a[4 * g + 3]) * u[4 * g + 3] * w); }
                store16_wt(Z + (size_t)ts * 256 + jb + 8 * gp + 8 * h, widen_pair(ob[0], ob[1])); } }
    }
};
struct EpiF {
    static constexpr int STAGED = 1;
    bf16_t* F; const LAS int* lt; int cnt, m00;
    DI void chunk(int m, int n, const f32x4& v, int lrow) const {
        if (m < cnt) { const int ts = lt[lrow]; u32x2 o; o.x = pk2(v.x, v.y); o.y = pk2(v.z, v.w); __builtin_nontemporal_store(o, (u32x2*)(F + (size_t)ts * 1024 + n)); }
    }
};
DI void stage_experts(const Ctx& c) {
    unsigned* ctl = c.ws<unsigned>(WS_CTL);
    LAS int* lcnt = (LAS int*)(c.lds + G_SCR);
    LAS int* lpre0 = lcnt + 32;
    LAS int* lpre1 = lpre0 + 33;
    LAS int* ltile = lcnt + 128;
    volatile LAS unsigned* slot = (volatile LAS unsigned*)(c.lds + LDS_MISC) + 8;
    __syncthreads();
    if (c.tid < 64) {
        const int cnt = c.tid < 32 ? (int)xb_ld(&ctl[CNT_IDX(c.tid & 31)]) : 0, mtl = (cnt + 255) >> 8;
        int incl = mtl;
#pragma unroll
        for (int o = 1; o < 32; o <<= 1) { const int t = __shfl_up(incl, o); if (c.lane >= o) incl += t; }
        if (c.tid < 32) { lcnt[c.tid] = cnt; lpre0[c.tid] = (incl - mtl) * 4; lpre1[c.tid] = (incl - mtl) * 8; }
        if (c.tid == 31) { lpre0[32] = incl * 4; lpre1[32] = incl * 8; }
    }
    __syncthreads();
    const int tot0 = lpre0[32], tot1 = lpre1[32];
#define EXP_DECODE(PRE, IT, SH, E, CNT, MT, NT) int E = 0; { _Pragma("unroll") for (int s_ = 16; s_ >= 1; s_ >>= 1) if (PRE[E + s_] <= (IT)) E += s_; } \
        const int CNT = lcnt[E], MT = ((IT) - PRE[E]) >> (SH), NT = ((IT) - PRE[E]) & ((1 << (SH)) - 1);
#define EXP_LIST(E, CNT, MT) (c.ws<int>(WS_LIST) + (E) * 16384)[((MT) * 256 + c.tid) < (CNT) ? ((MT) * 256 + c.tid) : (CNT) - 1]
    int buf = 0;
    if (c.vb < tot0) { EXP_DECODE(lpre0, c.vb, 2, e, cnt, mt, nt) (void)nt; if (c.tid < 256) ltile[c.tid] = EXP_LIST(e, cnt, mt); }
    for (int it = c.vb; it < tot0; it += c.G) {
        EXP_DECODE(lpre0, it, 2, e, cnt, mt, nt)
        int pre = 0; const int itn = it + c.G;
        if (itn < tot0) { EXP_DECODE(lpre0, itn, 2, en, cntn, mtn, ntn) (void)ntn; if (c.tid < 256) pre = EXP_LIST(en, cntn, mtn); }
        __syncthreads();
        LAS int* lt = ltile + buf * 256;
        GatherLoader al; al.src = c.ws<bf16_t>(WS_H); al.lt = lt; al.m00 = mt * 256; al.ld = 1024; al.shift = 1;
        RowLoader<2> wl; wl.base = c.ws<bf16_t>(WS_WGU) + (size_t)e * 512 * 1024; wl.ld = 1024; wl.nrows = 512;
        EpiZ epi{c.ws<bf16_t>(WS_Z), lt, c.ws<float>(WS_TOKW), cnt, mt * 256};
        gemm_tile(c, al, wl, mt * 256, nt * 128, 1024, epi, nullptr, -1);
        asm volatile("s_waitcnt vmcnt(0)" ::: "memory");
        __syncthreads();
        if (c.tid == 0) xb_add(&ctl[CW_ZCNT + 64 * e], 1u);
        if (itn < tot0 && c.tid < 256) ltile[(buf ^ 1) * 256 + c.tid] = pre;
        buf ^= 1;
    }
    unsigned confirmed = 0u;
    unsigned i1 = 0u;
    __syncthreads();
    if (c.tid == 0) { *slot = xb_add(&ctl[CW_X1HEAD], 1u); i1 = xb_add(&ctl[CW_X1HEAD], 1u); }
    __syncthreads();
    int cur = (int)*slot;
    buf = 0;
    if (cur < tot1) { EXP_DECODE(lpre1, cur, 3, e, cnt, mt, nt) (void)nt; if (c.tid < 256) ltile[c.tid] = EXP_LIST(e, cnt, mt); }
    while (cur < tot1) {
        __syncthreads();
        if (c.tid == 0) *slot = i1;
        __syncthreads();
        const int nx = (int)*slot;
        if (c.tid == 0) i1 = xb_add(&ctl[CW_X1HEAD], 1u);
        EXP_DECODE(lpre1, cur, 3, e, cnt, mt, nt)
        int pre = 0;
        if (nx < tot1) { EXP_DECODE(lpre1, nx, 3, en, cntn, mtn, ntn) (void)ntn; if (c.tid < 256) pre = EXP_LIST(en, cntn, mtn); }
        if (!((confirmed >> e) & 1u)) {
            if (c.tid == 0) {
                const unsigned need = (unsigned)(((cnt + 255) >> 8) * 4); unsigned* bar = ctl + CW_BAR;
                XB_SPIN(xb_ld(&ctl[CW_ZCNT + 64 * e]) < need, bar);
                __builtin_amdgcn_fence(__ATOMIC_ACQUIRE, "agent");
                asm volatile("s_waitcnt vmcnt(0)" ::: "memory");
            }
            __syncthreads();
            confirmed |= 1u << e;
        }
        LAS int* lt = ltile + buf * 256;
        GatherLoader al; al.src = c.ws<bf16_t>(WS_Z); al.lt = lt; al.m00 = mt * 256; al.ld = 256; al.shift = 0;
        RowLoader<2> wl; wl.base = c.ws<bf16_t>(WS_WD) + (size_t)e * 1024 * 256; wl.ld = 256; wl.nrows = 1024;
        EpiF epi{c.ws<bf16_t>(WS_F), lt, cnt, mt * 256};
        gemm_tile(c, al, wl, mt * 256, nt * 128, 256, epi, nullptr, -1);
        if (nx < tot1 && c.tid < 256) ltile[(buf ^ 1) * 256 + c.tid] = pre;
        buf ^= 1; cur = nx;
    }
#undef EXP_DECODE
#undef EXP_LIST
}

DI void stage_final(const Ctx& c) {
    const float* mod = c.ws<float>(WS_MOD); const bf16_t* F = c.ws<bf16_t>(WS_F); const bf16_t* Y = c.ws<bf16_t>(WS_Y1B);
    const int gw = c.bid * 8 + c.wid, nw = c.G * 8; float* outp = c.p.out; const float* stp = c.ws<float>(WS_STATS);
    for (int rbase = gw * 8; rbase < MLAT; rbase += nw * 8) {
        const int b = rbase >> 12;
        f32x4 pA[4], pB[4], pG[4];
#pragma unroll
        for (int j = 0; j < 4; ++j) { const int n = (c.lane + 64 * j) * 4;
            pA[j] = ALPHA * *(const f32x4*)(c.in(I_LN1G) + n); pB[j] = ALPHA * *(const f32x4*)(c.in(I_LN1B) + n); pG[j] = *(const f32x4*)(mod + (size_t)b * 6144 + 5120 + n);
        }
        const float* l2g = c.in(I_LN2G) + c.lane * 4; const float* l2b = c.in(I_LN2B) + c.lane * 4;
        u32x2 ya[2][4], fa[2][2][4], yb[2][4], fb[2][2][4]; f32x2 sa[2], sb[2];
#define FIN_LOAD(Y_, F_, S_, R0)                                                                                                      \
        _Pragma("unroll") for (int q = 0; q < 2; ++q) { const int row = (R0) + q;                                                     \
            S_[q] = *(const f32x2*)(stp + row * 2);                                                                                  \
            _Pragma("unroll") for (int j = 0; j < 4; ++j) {                                                                           \
                Y_[q][j] = __builtin_nontemporal_load((const u32x2*)(Y + ((row * 1024 + c.lane * 4) + j * 256)));                     \
                F_[q][0][j] = __builtin_nontemporal_load((const u32x2*)(F + ((row * 2048 + c.lane * 4) + j * 256)));                  \
                F_[q][1][j] = __builtin_nontemporal_load((const u32x2*)(F + ((row * 2048 + c.lane * 4) + (1024 + j * 256)))); } }             \
        __builtin_amdgcn_sched_barrier(0);
#define FIN_COMP(Y_, F_, S_, R0)                                                                                                      \
        _Pragma("unroll") for (int q = 0; q < 2; ++q) { const int row = (R0) + q;                                                     \
            f32x4 y[4]; float s = 0.f;                                                                                                \
            _Pragma("unroll") for (int j = 0; j < 4; ++j) {                                                                           \
                const f32x4 y1 = {lo16(Y_[q][j].x), hi16(Y_[q][j].x), lo16(Y_[q][j].y), hi16(Y_[q][j].y)};                            \
                f32x4 ff; ff.x = lo16(F_[q][0][j].x) + lo16(F_[q][1][j].x); ff.y = hi16(F_[q][0][j].x) + hi16(F_[q][1][j].x);         \
                ff.z = lo16(F_[q][0][j].y) + lo16(F_[q][1][j].y); ff.w = hi16(F_[q][0][j].y) + hi16(F_[q][1][j].y);                   \
                y[j] = (y1 - S_[q].x) * S_[q].y * pA[j] + pB[j] + pG[j] * ff; s += (y[j].x + y[j].y) + (y[j].z + y[j].w); }           \
            const float mean = wave_sum_fast(s) * (1.f / 1024.f); float qq = 0.f;                                                     \
            _Pragma("unroll") for (int j = 0; j < 4; ++j) { y[j] = y[j] - mean; qq += (y[j].x * y[j].x + y[j].y * y[j].y) + (y[j].z * y[j].z + y[j].w * y[j].w); } \
            const float rstd = rsqrtf(wave_sum_fast(qq) * (1.f / 1024.f) + EPS);                                                      \
            _Pragma("unroll") for (int j = 0; j < 4; ++j)                                                                             \
                __builtin_nontemporal_store(y[j] * rstd * *(const f32x4*)(l2g + j * 256) + *(const f32x4*)(l2b + j * 256), (f32x4*)(outp + ((row * 1024 + c.lane * 4) + j * 256)));                          \
            __builtin_amdgcn_sched_barrier(0); }
        FIN_LOAD(ya, fa, sa, rbase)
        FIN_LOAD(yb, fb, sb, rbase + 2)
        FIN_COMP(ya, fa, sa, rbase)
        FIN_LOAD(ya, fa, sa, rbase + 4)
        FIN_COMP(yb, fb, sb, rbase + 2)
        FIN_LOAD(yb, fb, sb, rbase + 6)
        FIN_COMP(ya, fa, sa, rbase + 4)
        FIN_COMP(yb, fb, sb, rbase + 6)
#undef FIN_LOAD
#undef FIN_COMP
    }
}

__global__ void __launch_bounds__(NT, 2) mega(Params p) {
    extern __shared__ __attribute__((aligned(16))) unsigned char lds_raw[];
    Ctx c; c.p = p; c.lds = (LAS unsigned char*)lds_raw; c.tid = threadIdx.x; c.lane = c.tid & 63; c.wid = __builtin_amdgcn_readfirstlane(c.tid >> 6); c.bid = blockIdx.x; c.G = gridDim.x; c.vb = (c.G % 8 == 0) ? (c.bid % 8) * (c.G / 8) + c.bid / 8 : c.bid;
    volatile LAS unsigned* misc = (volatile LAS unsigned*)(c.lds + LDS_MISC);
    if (c.tid < 16) misc[c.tid] = 0u;
    __syncthreads();
    unsigned* ctl = c.ws<unsigned>(WS_CTL);
    XcdBarrier bar = xcd_barrier_post(ctl + CW_BAR, misc);
#define BAR() xcd_barrier(bar)
    stage_prep(c); BAR();
    stage_s1(c); BAR();
    stage_inproj(c); bg_run(c, 0); BAR();
    stage_upproj(c); bg_run(c, 1); BAR();
    stage_carry(c); stage_attn(c, 0, 256);
    stage_ssmout(c); stage_attn(c, 256, 512);
    stage_glu(c); BAR();
    stage_wo(c);
    stage_ln1(c); BAR();
    stage_experts(c); BAR();
    stage_final(c);
}

extern "C" void kernel_launch(void* const* d_in, const int* in_sizes, int n_in, void* d_out, int out_size, void* d_ws, size_t ws_size, hipStream_t stream) {
    static int grid = 0;
    if (grid == 0) {
        int dev = 0, cus = 0, per_cu = 0;
        (void)hipGetDevice(&dev);
        (void)hipDeviceGetAttribute(&cus, hipDeviceAttributeMultiprocessorCount, dev);
        (void)hipFuncSetAttribute((const void*)mega, hipFuncAttributeMaxDynamicSharedMemorySize, LDS_BYTES);
        (void)hipOccupancyMaxActiveBlocksPerMultiprocessor(&per_cu, (const void*)mega, NT, LDS_BYTES);
        (void)hipGetLastError();
        if (per_cu < 1) fprintf(stderr, "kernel_launch: occupancy query reports %d workgroups per CU\n", per_cu);
        if (ws_size < 256 * MiB) fprintf(stderr, "kernel_launch: workspace too small: %zu\n", ws_size);
        grid = cus > 0 ? cus : 256;
    }
    (void)hipMemsetAsync((char*)d_ws + WS_CTL, 0, 64 * 1024, stream);
    Params p{};
    for (int i = 0; i < N_IN && i < n_in; ++i) p.in[i] = (const float*)d_in[i];
    p.out = (float*)d_out; p.ws = (unsigned char*)d_ws;
    hipLaunchKernelGGL(mega, dim3(grid), dim3(NT), LDS_BYTES, stream, p);
}
```
